# Optimizing an MI355X kernel written in HIP

```python
import math
import numpy as np
import jax
import jax.numpy as jnp
from jax import lax

D_MODEL = 1024
BATCH = 16
SEQ = 2048
DEPTH = 1

HEAD_DIM = 64
NSA_HEADS = 8
NSA_KV_HEADS = 2
NSA_REP = NSA_HEADS // NSA_KV_HEADS
CMP_LEN = 32
CMP_STRIDE = 16
CMP_HIDDEN = 256
SLC_LEN = 64
SLC_COUNT = 16
WINDOW = 512
DSA_HEADS = 8
KV_LATENT = 128
IDX_HEADS = 8
IDX_DIM = 64
IDX_TOPK_MAX = 256
N_HEADS_TOTAL = NSA_HEADS + DSA_HEADS
MIX_WIDTH = N_HEADS_TOTAL * HEAD_DIM
N_BUCKETS = 32
BUCKET_EXACT = 16
BUCKET_MAX_DIST = 128
N_EXPERTS = 32
TOP_K = 4
D_EXPERT = D_MODEL
SWIGLU_LIMIT = 7.0
SWIGLU_ALPHA = 1.702
MOE_BLOCK = 128
Q_BLOCK = 128
SLC_Q_BLOCK = 32
FORCE_SCORE = 1e4
LN_EPS = 1e-5
RMS_EPS = 1e-6
DEEPNORM_ALPHA = (2 * DEPTH) ** 0.25
DEEPNORM_BETA = (8 * DEPTH) ** -0.25
IN_SPLITS = (
    NSA_HEADS * HEAD_DIM,
    NSA_KV_HEADS * HEAD_DIM,
    NSA_KV_HEADS * HEAD_DIM,
    NSA_KV_HEADS * HEAD_DIM,
    NSA_KV_HEADS * HEAD_DIM,
    NSA_KV_HEADS * HEAD_DIM,
    NSA_KV_HEADS * HEAD_DIM,
    NSA_HEADS * 3,
    DSA_HEADS * HEAD_DIM,
    KV_LATENT,
    IDX_HEADS * IDX_DIM,
    IDX_DIM,
    IDX_HEADS,
)
IN_COLS = sum(IN_SPLITS)

kernel_name = 'hybrid_nsa_dsa_moe_deepnorm_block'


def layer_norm(x, g, b):
    xf = x.astype(jnp.float32)
    mu = jnp.mean(xf, -1, keepdims=True)
    var = jnp.mean(jnp.square(xf - mu), -1, keepdims=True)
    return ((xf - mu) * lax.rsqrt(var + LN_EPS) * g + b).astype(x.dtype)


def rms_norm(x, g):
    xf = x.astype(jnp.float32)
    return (xf * lax.rsqrt(jnp.mean(jnp.square(xf), -1, keepdims=True) + RMS_EPS) * g).astype(x.dtype)


def t5_bucket(dist):
    d = jnp.maximum(dist, 0)
    df = jnp.maximum(d, 1).astype(jnp.float32)
    large = BUCKET_EXACT + (jnp.log(df / BUCKET_EXACT) / math.log(BUCKET_MAX_DIST / BUCKET_EXACT)
                            * (N_BUCKETS - BUCKET_EXACT)).astype(jnp.int32)
    large = jnp.minimum(large, N_BUCKETS - 1)
    return jnp.where(d < BUCKET_EXACT, d, large)


def masked_softmax(logits, mask):
    l = jnp.where(mask, logits, -jnp.inf)
    m = jnp.max(l, -1, keepdims=True)
    m = jnp.where(jnp.isfinite(m), m, 0.0)
    e = jnp.where(mask, jnp.exp(l - m), 0.0)
    s = jnp.sum(e, -1, keepdims=True)
    return e / jnp.where(s > 0, s, 1.0)


def to_blocks(a, nb):
    return jnp.moveaxis(a.reshape(a.shape[0], nb, -1, *a.shape[2:]), 1, 0)


def from_blocks(o):
    o = jnp.moveaxis(o, 0, 1)
    return o.reshape(o.shape[0], -1, *o.shape[3:])


def cmp_block_index(S):
    n_c = (S - CMP_LEN) // CMP_STRIDE + 1
    return np.arange(n_c)[:, None] * CMP_STRIDE + np.arange(CMP_LEN)[None, :]


def cmp_to_slc_matrix(cmp_starts, n_slc):
    ss = np.arange(n_slc) * SLC_LEN
    ov = np.minimum(cmp_starts[:, None] + CMP_LEN, ss[None, :] + SLC_LEN) - np.maximum(cmp_starts[:, None], ss[None, :])
    return (np.clip(ov, 0, None) / CMP_STRIDE).astype(np.float32)


def compress_blocks(kv, blk_idx, pos, w1, w2):
    B, n_c = kv.shape[0], blk_idx.shape[0]
    blocks = kv[:, blk_idx] + pos[None, None, :, None, :]
    blocks = jnp.moveaxis(blocks, 3, 2).reshape(B, n_c, NSA_KV_HEADS, CMP_LEN * HEAD_DIM)
    return jax.nn.gelu(blocks @ w1) @ w2


def nsa_mixer(q, k_cmp, v_cmp, k_slc, v_slc, k_win, v_win, gates,
              cmp_k_pos, cmp_k_w1, cmp_k_w2, cmp_v_pos, cmp_v_w1, cmp_v_w2, tab):
    B, S = q.shape[:2]
    G, R, dh = NSA_KV_HEADS, NSA_REP, HEAD_DIM
    scale = dh ** -0.5
    q = q.reshape(B, S, G, R, dh)
    k_cmp, v_cmp, k_slc, v_slc, k_win, v_win = [a.reshape(B, S, G, dh) for a in (k_cmp, v_cmp, k_slc, v_slc, k_win, v_win)]
    tab = tab.reshape(N_BUCKETS, G, R)
    t = jnp.arange(S)

    blk_idx = cmp_block_index(S)
    kc = compress_blocks(k_cmp, blk_idx, cmp_k_pos, cmp_k_w1, cmp_k_w2)
    vc = compress_blocks(v_cmp, blk_idx, cmp_v_pos, cmp_v_w1, cmp_v_w2)
    dist_c = t[:, None] - jnp.asarray(blk_idx[:, -1])[None, :]
    bias_c = jnp.transpose(tab[t5_bucket(dist_c)], (2, 3, 0, 1))
    logits_c = jnp.einsum('bsgrd,bcgd->bgrsc', q, kc).astype(jnp.float32) * scale + bias_c
    p_c = masked_softmax(logits_c, dist_c >= 0)
    o_cmp = jnp.einsum('bgrsc,bcgd->bsgrd', p_c.astype(vc.dtype), vc)

    n_slc = S // SLC_LEN
    n_sel = min(SLC_COUNT, n_slc)
    imp = jnp.einsum('bgrsc,cj->bgsj', p_c, jnp.asarray(cmp_to_slc_matrix(blk_idx[:, 0], n_slc)))
    j = jnp.arange(n_slc)[None, :]
    tb = (t // SLC_LEN)[:, None]
    valid = j <= tb
    forced = valid & ((j == 0) | (j >= tb - 1))
    score = jnp.where(valid, jnp.where(forced, FORCE_SCORE, imp), -jnp.inf)
    top_sc, top_idx = lax.top_k(score, n_sel)
    top_ok = top_sc > -jnp.inf
    kb = k_slc.reshape(B, n_slc, SLC_LEN, G, dh).transpose(0, 3, 1, 2, 4)
    vb = v_slc.reshape(B, n_slc, SLC_LEN, G, dh).transpose(0, 3, 1, 2, 4)
    tab_g = jnp.transpose(tab, (1, 0, 2))
    b_ix = jnp.arange(B)[:, None, None, None]
    g_ix = jnp.arange(G)[None, :, None, None]
    nqs = S // SLC_Q_BLOCK

    def slc_block(args):
        qi, qb, ib, okb = args
        tq = qi * SLC_Q_BLOCK + jnp.arange(SLC_Q_BLOCK)
        ks = kb[b_ix, g_ix, ib]
        vs = vb[b_ix, g_ix, ib]
        pos = ib[..., None] * SLC_LEN + jnp.arange(SLC_LEN)
        dist = tq[None, None, :, None, None] - pos
        mask = (okb[..., None] & (dist >= 0)).reshape(B, G, 1, SLC_Q_BLOCK, n_sel * SLC_LEN)
        bias = jnp.moveaxis(tab_g[g_ix[..., None], t5_bucket(dist)], -1, 2)
        logits = jnp.einsum('bqgrd,bgqnud->bgrqnu', qb, ks).astype(jnp.float32) * scale + bias
        p = masked_softmax(logits.reshape(B, G, R, SLC_Q_BLOCK, n_sel * SLC_LEN), mask)
        return jnp.einsum('bgrqn,bgqnd->bqgrd', p.astype(vs.dtype),
                          vs.reshape(B, G, SLC_Q_BLOCK, n_sel * SLC_LEN, dh))

    idx_blocks = jnp.moveaxis(top_idx.reshape(B, G, nqs, SLC_Q_BLOCK, n_sel), 2, 0)
    ok_blocks = jnp.moveaxis(top_ok.reshape(B, G, nqs, SLC_Q_BLOCK, n_sel), 2, 0)
    o_slc = from_blocks(lax.map(slc_block, (jnp.arange(nqs), to_blocks(q, nqs), idx_blocks, ok_blocks)))

    kp = jnp.pad(k_win, ((0, 0), (WINDOW, 0), (0, 0), (0, 0)))
    vp = jnp.pad(v_win, ((0, 0), (WINDOW, 0), (0, 0), (0, 0)))
    span = WINDOW + Q_BLOCK
    nqw = S // Q_BLOCK

    def win_block(args):
        qi, qb = args
        start = qi * Q_BLOCK
        kw = lax.dynamic_slice_in_dim(kp, start, span, axis=1)
        vw = lax.dynamic_slice_in_dim(vp, start, span, axis=1)
        tq = start + jnp.arange(Q_BLOCK)
        pos = start - WINDOW + jnp.arange(span)
        dist = tq[:, None] - pos[None, :]
        mask = (dist >= 0) & (dist < WINDOW) & (pos[None, :] >= 0)
        bias = jnp.transpose(tab[t5_bucket(dist)], (2, 3, 0, 1))
        logits = jnp.einsum('bqgrd,bkgd->bgrqk', qb, kw).astype(jnp.float32) * scale + bias
        p = masked_softmax(logits, mask)
        return jnp.einsum('bgrqk,bkgd->bqgrd', p.astype(vw.dtype), vw)

    o_win = from_blocks(lax.map(win_block, (jnp.arange(nqw), to_blocks(q, nqw))))

    g = jax.nn.sigmoid(gates.astype(jnp.float32)).reshape(B, S, G, R, 3).astype(q.dtype)
    o = g[..., 0:1] * o_cmp + g[..., 1:2] * o_slc + g[..., 2:3] * o_win
    return o.reshape(B, S, NSA_HEADS * dh)


def dsa_mixer(q, c_kv, q_idx, k_idx, w_idx, ckv_gain, kidx_gain, kidx_bias, w_uk, w_uv, tab):
    B, S = q.shape[:2]
    scale = HEAD_DIM ** -0.5
    q = q.reshape(B, S, DSA_HEADS, HEAD_DIM)
    ckv = rms_norm(c_kv, ckv_gain)
    q_abs = jnp.einsum('bshd,hcd->bshc', q, w_uk)
    qi = q_idx.reshape(B, S, IDX_HEADS, IDX_DIM)
    ki = layer_norm(k_idx, kidx_gain, kidx_bias)
    wi = w_idx * (IDX_HEADS ** -0.5 * IDX_DIM ** -0.5)
    k_top = min(IDX_TOPK_MAX, S // 4)
    nq = S // Q_BLOCK
    s_pos = jnp.arange(S)
    b_ix = jnp.arange(B)[:, None, None]

    def dsa_block(args):
        n, qab, qib, wib = args
        tq = n * Q_BLOCK + jnp.arange(Q_BLOCK)
        rel = jax.nn.relu(jnp.einsum('bqhd,bsd->bqhs', qib, ki).astype(jnp.float32))
        score = jnp.einsum('bqhs,bqh->bqs', rel, wib.astype(jnp.float32))
        score = jnp.where(s_pos[None, :] <= tq[:, None], score, -jnp.inf)
        top_sc, top_idx = lax.top_k(score, k_top)
        ok = top_sc > -jnp.inf
        cs = ckv[b_ix, top_idx]
        bias = jnp.moveaxis(tab[t5_bucket(tq[None, :, None] - top_idx)], -1, 1)
        logits = jnp.einsum('bqhc,bqkc->bhqk', qab, cs).astype(jnp.float32) * scale + bias
        p = masked_softmax(logits, ok[:, None])
        oc = jnp.einsum('bhqk,bqkc->bqhc', p.astype(cs.dtype), cs)
        return jnp.einsum('bqhc,hcd->bqhd', oc, w_uv)

    o = from_blocks(lax.map(dsa_block, (jnp.arange(nq), to_blocks(q_abs, nq), to_blocks(qi, nq), to_blocks(wi, nq))))
    return o.reshape(B, S, DSA_HEADS * HEAD_DIM)


def moe_ffn(h, w_router, b_router, w_gate, b_gate, w_up, b_up, w_down, b_down):
    T, D = h.shape
    logits = (h @ w_router + b_router).astype(jnp.float32)
    top_val, top_exp = lax.top_k(logits, TOP_K)
    gate_w = jax.nn.softmax(top_val, axis=-1)
    n_assign = T * TOP_K
    flat_e = top_exp.reshape(-1)
    order = jnp.argsort(flat_e)
    sorted_e = flat_e[order]
    sorted_tok = (jnp.arange(n_assign) // TOP_K)[order]
    sorted_w = gate_w.reshape(-1)[order]
    counts = jnp.bincount(flat_e, length=N_EXPERTS)
    padded = (counts + MOE_BLOCK - 1) // MOE_BLOCK * MOE_BLOCK
    pad_end = jnp.cumsum(padded)
    pad_start = pad_end - padded
    grp_start = jnp.cumsum(counts) - counts
    dest = pad_start[sorted_e] + jnp.arange(n_assign) - grp_start[sorted_e]
    n_rows = -(-n_assign // MOE_BLOCK) * MOE_BLOCK + N_EXPERTS * MOE_BLOCK
    n_blocks = n_rows // MOE_BLOCK
    x_pad = jnp.zeros((n_rows, D), h.dtype).at[dest].set(h[sorted_tok])
    blk_e = jnp.minimum(jnp.searchsorted(pad_end, jnp.arange(n_blocks) * MOE_BLOCK, side='right'), N_EXPERTS - 1)

    def expert_block(args):
        xb, e = args
        gt = jnp.minimum(xb @ w_gate[e] + b_gate[e], SWIGLU_LIMIT)
        up = jnp.clip(xb @ w_up[e] + b_up[e], -SWIGLU_LIMIT, SWIGLU_LIMIT)
        return (gt * jax.nn.sigmoid(SWIGLU_ALPHA * gt) * (up + 1.0)) @ w_down[e] + b_down[e]

    y_pad = lax.map(expert_block, (x_pad.reshape(n_blocks, MOE_BLOCK, D), blk_e)).reshape(n_rows, D)
    y = jax.ops.segment_sum(y_pad[dest] * sorted_w[:, None].astype(h.dtype), sorted_tok, num_segments=T)
    return y.astype(h.dtype)


def setup_inputs(seed: int = 0) -> dict:
    key = jax.random.key(seed)
    ks = jax.random.split(key, 40)
    L, D, E, F = DEPTH, D_MODEL, N_EXPERTS, D_EXPERT

    def nrm(k, shape, s):
        return jax.random.normal(k, shape, jnp.float32) * s

    return {
        'x': nrm(ks[0], (BATCH, SEQ, D), 1.0),
        'c': nrm(ks[1], (BATCH, D), 1.0),
        'w_ada': nrm(ks[2], (L, D, 6 * D), 0.2 * D ** -0.5),
        'b_ada': nrm(ks[3], (L, 6 * D), 0.01),
        'w_in': nrm(ks[4], (L, D, IN_COLS), D ** -0.5),
        'cmp_k_pos': nrm(ks[5], (L, CMP_LEN, HEAD_DIM), 0.1),
        'cmp_k_w1': nrm(ks[6], (L, CMP_LEN * HEAD_DIM, CMP_HIDDEN), (CMP_LEN * HEAD_DIM) ** -0.5),
        'cmp_k_w2': nrm(ks[7], (L, CMP_HIDDEN, HEAD_DIM), CMP_HIDDEN ** -0.5),
        'cmp_v_pos': nrm(ks[8], (L, CMP_LEN, HEAD_DIM), 0.1),
        'cmp_v_w1': nrm(ks[9], (L, CMP_LEN * HEAD_DIM, CMP_HIDDEN), (CMP_LEN * HEAD_DIM) ** -0.5),
        'cmp_v_w2': nrm(ks[10], (L, CMP_HIDDEN, HEAD_DIM), CMP_HIDDEN ** -0.5),
        'ckv_gain': 1.0 + nrm(ks[11], (L, KV_LATENT), 0.02),
        'kidx_gain': 1.0 + nrm(ks[12], (L, IDX_DIM), 0.02),
        'kidx_bias': nrm(ks[13], (L, IDX_DIM), 0.02),
        'w_uk': nrm(ks[14], (L, DSA_HEADS, KV_LATENT, HEAD_DIM), HEAD_DIM ** -0.5),
        'w_uv': nrm(ks[15], (L, DSA_HEADS, KV_LATENT, HEAD_DIM), KV_LATENT ** -0.5),
        'nsa_out_gain': 1.0 + nrm(ks[16], (L, NSA_HEADS * HEAD_DIM), 0.02),
        'dsa_out_gain': 1.0 + nrm(ks[17], (L, DSA_HEADS * HEAD_DIM), 0.02),
        'rel_bias': nrm(ks[18], (N_BUCKETS, N_HEADS_TOTAL), 0.5),
        'w_out': nrm(ks[19], (L, MIX_WIDTH, D), DEEPNORM_BETA * MIX_WIDTH ** -0.5),
        'ln1_gain': 1.0 + nrm(ks[20], (L, D), 0.02),
        'ln1_bias': nrm(ks[21], (L, D), 0.02),
        'w_router': nrm(ks[22], (L, D, E), D ** -0.5),
        'b_router': nrm(ks[23], (L, E), 0.01),
        'w_gate': nrm(ks[24], (L, E, D, F), D ** -0.5),
        'b_gate': nrm(ks[25], (L, E, F), 0.01),
        'w_up': nrm(ks[26], (L, E, D, F), D ** -0.5),
        'b_up': nrm(ks[27], (L, E, F), 0.01),
        'w_down': nrm(ks[28], (L, E, F, D), DEEPNORM_BETA * F ** -0.5),
        'b_down': nrm(ks[29], (L, E, D), 0.01),
        'ln2_gain': 1.0 + nrm(ks[30], (L, D), 0.02),
        'ln2_bias': nrm(ks[31], (L, D), 0.02),
    }


def reference(x, c, w_ada, b_ada, w_in, cmp_k_pos, cmp_k_w1, cmp_k_w2, cmp_v_pos, cmp_v_w1, cmp_v_w2,
              ckv_gain, kidx_gain, kidx_bias, w_uk, w_uv, nsa_out_gain, dsa_out_gain, rel_bias, w_out,
              ln1_gain, ln1_bias, w_router, b_router, w_gate, b_gate, w_up, b_up, w_down, b_down,
              ln2_gain, ln2_bias):
    B, S, D = x.shape
    split_points = [int(p) for p in np.cumsum(IN_SPLITS)[:-1]]
    for l in range(DEPTH):
        ada = jax.nn.silu(c) @ w_ada[l] + b_ada[l]
        sh1, sc1, g1, sh2, sc2, g2 = [a[:, None, :] for a in jnp.split(ada, 6, axis=-1)]

        h = x * (1.0 + sc1) + sh1
        cols = jnp.split(h @ w_in[l], split_points, axis=-1)
        (q_n, kc_n, vc_n, ks_n, vs_n, kw_n, vw_n, gate_n, q_d, ckv_d, qi_d, ki_d, wi_d) = cols
        o_nsa = nsa_mixer(q_n, kc_n, vc_n, ks_n, vs_n, kw_n, vw_n, gate_n,
                          cmp_k_pos[l], cmp_k_w1[l], cmp_k_w2[l], cmp_v_pos[l], cmp_v_w1[l], cmp_v_w2[l],
                          rel_bias[:, :NSA_HEADS])
        o_dsa = dsa_mixer(q_d, ckv_d, qi_d, ki_d, wi_d, ckv_gain[l], kidx_gain[l], kidx_bias[l],
                          w_uk[l], w_uv[l], rel_bias[:, NSA_HEADS:])
        mix = jnp.concatenate([rms_norm(o_nsa, nsa_out_gain[l]), rms_norm(o_dsa, dsa_out_gain[l])], axis=-1)
        y = mix @ w_out[l]
        x = layer_norm(DEEPNORM_ALPHA * x + (1.0 + g1) * y, ln1_gain[l], ln1_bias[l])

        h = x * (1.0 + sc2) + sh2
        y = moe_ffn(h.reshape(B * S, D), w_router[l], b_router[l], w_gate[l], b_gate[l],
                    w_up[l], b_up[l], w_down[l], b_down[l]).reshape(B, S, D)
        x = layer_norm(DEEPNORM_ALPHA * x + (1.0 + g2) * y, ln2_gain[l], ln2_bias[l])
    return x
```

```cpp
#include <hip/hip_runtime.h>
#include <stdint.h>

namespace {
constexpr int B_ = 16, S_ = 2048, D_ = 1024, T_ = B_ * S_;
constexpr int INC = 2528;
constexpr int O_QN = 0, O_KC = 512, O_VC = 640, O_KS = 768, O_VS = 896, O_KW = 1024, O_VW = 1152, O_GATE = 1280,
              O_QD = 1304, O_CKV = 1816, O_QI = 1944, O_KI = 2456, O_WI = 2520;
constexpr int NC = 127, NCR = B_ * NC * 2;
constexpr int NCHUNK = 4, CHT = T_ / NCHUNK;
constexpr float ALPHA = 1.189207115002721f;
constexpr size_t MiB = 1u << 20;
constexpr size_t W_CNT = 0;
constexpr size_t W_ADA = 1 * MiB;
constexpr size_t W_KC = 2 * MiB, W_VC = 4 * MiB;
constexpr size_t W_H1K = 6 * MiB, W_H1V = 11 * MiB;
constexpr size_t W_KILN = 16 * MiB;
constexpr size_t W_CKVN = 24 * MiB;
constexpr size_t W_TOPE = 40 * MiB, W_TOPW = 41 * MiB;
constexpr size_t W_LIST = 42 * MiB;
constexpr size_t W_COLS = 64 * MiB;
constexpr size_t W_MIX = 380 * MiB;
constexpr size_t W_H2 = 64 * MiB;
constexpr size_t W_ACT = 192 * MiB;
constexpr size_t W_YK = 320 * MiB;

__constant__ unsigned char c_bucket[128] = {
    0, 1, 2, 3, 4, 5, 6, 7, 8, 9, 10, 11, 12, 13, 14, 15, 16, 16, 16, 17, 17, 18, 18, 18, 19, 19, 19, 20, 20, 20, 20, 21,
    21, 21, 21, 22, 22, 22, 22, 22, 23, 23, 23, 23, 23, 23, 24, 24, 24, 24, 24, 24, 25, 25, 25, 25, 25, 25, 25, 26, 26, 26, 26, 26,
    26, 26, 26, 27, 27, 27, 27, 27, 27, 27, 27, 27, 27, 28, 28, 28, 28, 28, 28, 28, 28, 28, 28, 29, 29, 29, 29, 29, 29, 29, 29, 29,
    29, 29, 29, 30, 30, 30, 30, 30, 30, 30, 30, 30, 30, 30, 30, 30, 30, 31, 31, 31, 31, 31, 31, 31, 31, 31, 31, 31, 31, 31, 31, 31};
__device__ __forceinline__ int bucket(int d) { return d >= 128 ? 31 : (int)c_bucket[d]; }

__device__ __forceinline__ float wsum(float v) { for (int o = 32; o > 0; o >>= 1) v += __shfl_xor(v, o); return v; }
__device__ __forceinline__ float wmax(float v) { for (int o = 32; o > 0; o >>= 1) v = fmaxf(v, __shfl_xor(v, o)); return v; }
__device__ __forceinline__ int wsumi(int v) { for (int o = 32; o > 0; o >>= 1) v += __shfl_xor(v, o); return v; }

struct P {
    const float* in[32];
    float* out;
    unsigned char* ws;
};
#define WS(T, off) ((T*)(p.ws + (off)))

__global__ void __launch_bounds__(256) k_ada(P p) {
    const int j = blockIdx.x * 256 + threadIdx.x;
    const float* c = p.in[1]; const float* w = p.in[2]; const float* bb = p.in[3];
    __shared__ float sc[16][64];
    float acc[16];
#pragma unroll
    for (int b = 0; b < 16; ++b) acc[b] = 0.f;
    for (int k0 = 0; k0 < 1024; k0 += 64) {
        __syncthreads();
        for (int i = threadIdx.x; i < 1024; i += 256) { const int b = i >> 6, k = i & 63; const float v = c[b * 1024 + k0 + k]; sc[b][k] = v / (1.f + expf(-v)); }
        __syncthreads();
        for (int k = 0; k < 64; ++k) { const float wv = w[(size_t)(k0 + k) * 6144 + j];
#pragma unroll
            for (int b = 0; b < 16; ++b) acc[b] += sc[b][k] * wv; }
    }
    float* ada = WS(float, W_ADA);
#pragma unroll
    for (int b = 0; b < 16; ++b) ada[b * 6144 + j] = acc[b] + bb[j];
}

template <bool DUAL, class AL, class EP>
__device__ __forceinline__ void gemm128(const AL& al, const float* __restrict__ Bm, const float* __restrict__ Bm2, int ldb, int K, int n0, int N, const EP& ep, float* lds) {
    const int tid = threadIdx.x, ty = tid >> 5, tx = tid & 31;
    float acc[8][4], acc2[8][4];
#pragma unroll
    for (int i = 0; i < 8; ++i)
#pragma unroll
        for (int j = 0; j < 4; ++j) { acc[i][j] = 0.f; acc2[i][j] = 0.f; }
    float* As = lds; float* Bs = lds + 16 * 132; float* Bs2 = Bs + 16 * 128;
    const int ar = tid >> 2, ak = (tid & 3) * 4, bk = tid >> 5, bn = (tid & 31) * 4;
    const bool bok = (n0 + bn) < N;
    for (int k0 = 0; k0 < K; k0 += 16) {
        const float4 av = al.load(ar, k0 + ak);
        float4 bv = make_float4(0.f, 0.f, 0.f, 0.f), bv2 = bv;
        if (bok) { bv = *(const float4*)(Bm + (size_t)(k0 + bk) * ldb + n0 + bn); if (DUAL) bv2 = *(const float4*)(Bm2 + (size_t)(k0 + bk) * ldb + n0 + bn); }
        __syncthreads();
        As[(ak + 0) * 132 + ar] = av.x; As[(ak + 1) * 132 + ar] = av.y; As[(ak + 2) * 132 + ar] = av.z; As[(ak + 3) * 132 + ar] = av.w;
        *(float4*)(Bs + bk * 128 + bn) = bv;
        if (DUAL) *(float4*)(Bs2 + bk * 128 + bn) = bv2;
        __syncthreads();
#pragma unroll
        for (int k = 0; k < 16; ++k) {
            const float4 a0 = *(const float4*)(As + k * 132 + ty * 8), a1 = *(const float4*)(As + k * 132 + ty * 8 + 4);
            const float4 b = *(const float4*)(Bs + k * 128 + tx * 4);
            const float a[8] = {a0.x, a0.y, a0.z, a0.w, a1.x, a1.y, a1.z, a1.w};
            const float bb[4] = {b.x, b.y, b.z, b.w};
#pragma unroll
            for (int i = 0; i < 8; ++i)
#pragma unroll
                for (int j = 0; j < 4; ++j) acc[i][j] += a[i] * bb[j];
            if (DUAL) {
                const float4 b2 = *(const float4*)(Bs2 + k * 128 + tx * 4);
                const float bb2[4] = {b2.x, b2.y, b2.z, b2.w};
#pragma unroll
                for (int i = 0; i < 8; ++i)
#pragma unroll
                    for (int j = 0; j < 4; ++j) acc2[i][j] += a[i] * bb2[j];
            }
        }
    }
    const int col = n0 + tx * 4;
    if (col < N) {
#pragma unroll
        for (int i = 0; i < 8; ++i)
            ep(ty * 8 + i, col, make_float4(acc[i][0], acc[i][1], acc[i][2], acc[i][3]), make_float4(acc2[i][0], acc2[i][1], acc2[i][2], acc2[i][3]));
    }
    __syncthreads();
}
constexpr int GEMM_LDS_FLOATS = 16 * 132 + 2 * 16 * 128;

struct AL_in { const float* x; const float* ada; int m0;
    __device__ __forceinline__ float4 load(int r, int k) const { const int row = m0 + r, b = row >> 11; const float4 xv = *(const float4*)(x + (size_t)row * 1024 + k);
        const float4 sh = *(const float4*)(ada + b * 6144 + k), sc = *(const float4*)(ada + b * 6144 + 1024 + k);
        return make_float4(xv.x * (1.f + sc.x) + sh.x, xv.y * (1.f + sc.y) + sh.y, xv.z * (1.f + sc.z) + sh.z, xv.w * (1.f + sc.w) + sh.w); } };
struct EP_store { float* C; int ldc; int m0;
    __device__ __forceinline__ void operator()(int r, int col, float4 v, float4) const { *(float4*)(C + (size_t)(m0 + r) * ldc + col) = v; } };
__global__ void __launch_bounds__(512) k_win(P p) {
    __shared__ float lds[GEMM_LDS_FLOATS];
    const int m0 = blockIdx.y * 128, n0 = blockIdx.x * 128;
    AL_in al{p.in[0], WS(float, W_ADA), m0}; EP_store ep{WS(float, W_COLS), INC, m0};
    gemm128<false>(al, p.in[4], nullptr, INC, 1024, n0, INC, ep, lds);
}

struct AL_cmp { const float* cols; const float* pos; int m0; int off;
    __device__ __forceinline__ float4 load(int r, int k) const { const int m = m0 + r; if (m >= NCR) return make_float4(0.f, 0.f, 0.f, 0.f);
        const int b = m / 254, rem = m % 254, c = rem >> 1, g = rem & 1, l = k >> 6, d = k & 63;
        const float4 v = *(const float4*)(cols + (size_t)(b * 2048 + 16 * c + l) * INC + off + g * 64 + d); const float4 pv = *(const float4*)(pos + l * 64 + d);
        return make_float4(v.x + pv.x, v.y + pv.y, v.z + pv.z, v.w + pv.w); } };
__device__ __forceinline__ float gelu_t(float x) { return 0.5f * x * (1.f + tanhf(0.7978845608028654f * (x + 0.044715f * x * x * x))); }
struct EP_gelu { float* C; int ldc; int m0; int M;
    __device__ __forceinline__ void operator()(int r, int col, float4 v, float4) const { if (m0 + r < M) *(float4*)(C + (size_t)(m0 + r) * ldc + col) = make_float4(gelu_t(v.x), gelu_t(v.y), gelu_t(v.z), gelu_t(v.w)); } };
__global__ void __launch_bounds__(512) k_cmp1(P p) {
    __shared__ float lds[GEMM_LDS_FLOATS];
    const int kv = blockIdx.z, m0 = blockIdx.y * 128, n0 = blockIdx.x * 128;
    AL_cmp al{WS(float, W_COLS), p.in[kv ? 8 : 5], m0, kv ? O_VC : O_KC}; EP_gelu ep{WS(float, kv ? W_H1V : W_H1K), 256, m0, NCR};
    gemm128<false>(al, p.in[kv ? 9 : 6], nullptr, 256, 2048, n0, 256, ep, lds);
}
struct AL_rows { const float* A; int lda; int m0; int M;
    __device__ __forceinline__ float4 load(int r, int k) const { const int m = m0 + r; if (m >= M) return make_float4(0.f, 0.f, 0.f, 0.f); return *(const float4*)(A + (size_t)m * lda + k); } };
struct EP_storeM { float* C; int ldc; int m0; int M;
    __device__ __forceinline__ void operator()(int r, int col, float4 v, float4) const { if (m0 + r < M) *(float4*)(C + (size_t)(m0 + r) * ldc + col) = v; } };
__global__ void __launch_bounds__(512) k_cmp2(P p) {
    __shared__ float lds[GEMM_LDS_FLOATS];
    const int kv = blockIdx.z, m0 = blockIdx.y * 128;
    AL_rows al{WS(float, kv ? W_H1V : W_H1K), 256, m0, NCR}; EP_storeM ep{WS(float, kv ? W_VC : W_KC), 64, m0, NCR};
    gemm128<false>(al, p.in[kv ? 10 : 7], nullptr, 64, 256, 0, 64, ep, lds);
}

__global__ void __launch_bounds__(256) k_prep(P p) {
    const int tok = blockIdx.x * 4 + (threadIdx.x >> 6), lane = threadIdx.x & 63;
    const float* crow = WS(float, W_COLS) + (size_t)tok * INC;
    const float a0 = crow[O_CKV + lane], a1 = crow[O_CKV + 64 + lane];
    const float ss = wsum(a0 * a0 + a1 * a1);
    const float r = rsqrtf(ss * (1.f / 128.f) + 1e-6f);
    float* ck = WS(float, W_CKVN) + (size_t)tok * 128;
    ck[lane] = a0 * r * p.in[11][lane]; ck[64 + lane] = a1 * r * p.in[11][64 + lane];
    const float kv = crow[O_KI + lane];
    const float mu = wsum(kv) * (1.f / 64.f);
    const float dv = kv - mu;
    const float var = wsum(dv * dv) * (1.f / 64.f);
    WS(float, W_KILN)[(size_t)tok * 64 + lane] = dv * rsqrtf(var + 1e-5f) * p.in[12][lane] + p.in[13][lane];
}

__device__ __forceinline__ float dot64(const float* q, const float* kp) {
    float a = 0.f;
#pragma unroll 4
    for (int i = 0; i < 16; ++i) { const float4 kv = ((const float4*)kp)[i]; const float4 qv = ((const float4*)q)[i]; a += kv.x * qv.x + kv.y * qv.y + kv.z * qv.z + kv.w * qv.w; }
    return a;
}

__global__ void __launch_bounds__(512) k_nsa(P p) {
    __shared__ __attribute__((aligned(16))) float qs[8][64];
    __shared__ float pc[8][128];
    __shared__ float impS[2][32];
    __shared__ unsigned selm[2];
    __shared__ float lg[8][1024];
    __shared__ float red[8];
    const float* cols = WS(float, W_COLS); const float* kc = WS(float, W_KC); const float* vc = WS(float, W_VC);
    const float* relb = p.in[18];
    const int tid = threadIdx.x, h = tid >> 6, lane = tid & 63, g = h >> 2;
    const float NINF = -INFINITY;
    for (int u = blockIdx.x; u < T_; u += gridDim.x) {
        const int b = u >> 11, t = u & 2047;
        const float* crow = cols + (size_t)u * INC;
        const float* bbase = cols + (size_t)(b * 2048) * INC;
        __syncthreads();
        qs[h][lane] = crow[O_QN + h * 64 + lane];
        __syncthreads();
        float mx = NINF;
#pragma unroll 1
        for (int i = 0; i < 2; ++i) { const int c = lane + 64 * i; float l = NINF;
            if (c < NC && 16 * c + 31 <= t) l = dot64(qs[h], kc + ((size_t)(b * NC + c) * 2 + g) * 64) * 0.125f + relb[bucket(t - (16 * c + 31)) * 16 + h];
            pc[h][c] = l; mx = fmaxf(mx, l); }
        mx = wmax(mx);
        float sum = 0.f;
        const float l0 = pc[h][lane], l1 = pc[h][lane + 64];
        const float e0 = (l0 > NINF) ? expf(l0 - mx) : 0.f, e1 = (l1 > NINF) ? expf(l1 - mx) : 0.f;
        sum = wsum(e0 + e1);
        const float inv = sum > 0.f ? 1.f / sum : 0.f;
        pc[h][lane] = e0 * inv; pc[h][lane + 64] = e1 * inv;
        __syncthreads();
        float ocmp = 0.f;
        { const int ncv = (t >= 31) ? ((t - 31) / 16 + 1 < NC ? (t - 31) / 16 + 1 : NC) : 0;
          for (int c = 0; c < ncv; ++c) ocmp += pc[h][c] * vc[((size_t)(b * NC + c) * 2 + g) * 64 + lane]; }
        if ((h & 3) == 0 && lane < 32) { const int j = lane; float s = 0.f;
            for (int r = 0; r < 4; ++r) { const float* pp = pc[g * 4 + r]; const int c0 = 4 * j;
                s += (c0 >= 1 ? pp[c0 - 1] : 0.f) + 2.f * (pp[c0] + pp[c0 + 1] + pp[c0 + 2]) + pp[c0 + 3]; }
            impS[g][j] = s; }
        __syncthreads();
        if ((h & 3) == 0) { const int tb = t >> 6, j = lane; bool sel = false;
            if (j < 32) {
                if (tb < 16) sel = j <= tb;
                else if (j == 0 || j == tb || j == tb - 1) sel = true;
                else if (j <= tb - 2) { const float mi = impS[g][j]; int rank = 0;
                    for (int jj = 1; jj <= tb - 2; ++jj) { const float o = impS[g][jj]; rank += (o > mi) || (o == mi && jj < j); }
                    sel = rank < 13; } }
            const unsigned long long bal = __ballot(sel); if (lane == 0) selm[g] = (unsigned)bal; }
        __syncthreads();
        const unsigned m = selm[g];
        float oslc = 0.f;
        { int cnt = 0; mx = NINF;
#pragma unroll 1
          for (int j = 0; j < 32; ++j) if ((m >> j) & 1u) { const int key = 64 * j + lane; float l = NINF;
              if (key <= t) l = dot64(qs[h], bbase + (size_t)key * INC + O_KS + g * 64) * 0.125f + relb[bucket(t - key) * 16 + h];
              lg[h][cnt * 64 + lane] = l; mx = fmaxf(mx, l); ++cnt; }
          mx = wmax(mx); sum = 0.f;
          for (int i = 0; i < cnt; ++i) { const float l = lg[h][i * 64 + lane]; const float ee = (l > NINF) ? expf(l - mx) : 0.f; lg[h][i * 64 + lane] = ee; sum += ee; }
          sum = wsum(sum);
          __syncthreads();
          cnt = 0;
#pragma unroll 1
          for (int j = 0; j < 32; ++j) if ((m >> j) & 1u) {
#pragma unroll 4
              for (int kk = 0; kk < 64; ++kk) { const int key = 64 * j + kk; if (key > t) break; oslc += lg[h][cnt * 64 + kk] * bbase[(size_t)key * INC + O_VS + g * 64 + lane]; }
              ++cnt; }
          oslc *= 1.f / sum; }
        __syncthreads();
        float owin = 0.f;
        { mx = NINF;
#pragma unroll 1
          for (int i = 0; i < 8; ++i) { const int key = t - 511 + 64 * i + lane; float l = NINF;
              if (key >= 0) l = dot64(qs[h], bbase + (size_t)key * INC + O_KW + g * 64) * 0.125f + relb[bucket(t - key) * 16 + h];
              lg[h][i * 64 + lane] = l; mx = fmaxf(mx, l); }
          mx = wmax(mx); sum = 0.f;
          for (int i = 0; i < 8; ++i) { const float l = lg[h][i * 64 + lane]; const float ee = (l > NINF) ? expf(l - mx) : 0.f; lg[h][i * 64 + lane] = ee; sum += ee; }
          sum = wsum(sum);
          __syncthreads();
#pragma unroll 4
          for (int i = 0; i < 512; ++i) { const int key = t - 511 + i; if (key < 0) continue; owin += lg[h][i] * bbase[(size_t)key * INC + O_VW + g * 64 + lane]; }
          owin *= 1.f / sum; }
        const float g0 = 1.f / (1.f + expf(-crow[O_GATE + h * 3 + 0])), g1 = 1.f / (1.f + expf(-crow[O_GATE + h * 3 + 1])), g2 = 1.f / (1.f + expf(-crow[O_GATE + h * 3 + 2]));
        const float o = g0 * ocmp + g1 * oslc + g2 * owin;
        const float ss = wsum(o * o);
        if (lane == 0) red[h] = ss;
        __syncthreads();
        float tot = 0.f;
#pragma unroll
        for (int i = 0; i < 8; ++i) tot += red[i];
        const float r = rsqrtf(tot * (1.f / 512.f) + 1e-6f);
        WS(float, W_MIX)[(size_t)u * 1024 + h * 64 + lane] = o * r * p.in[16][h * 64 + lane];
    }
}

__device__ __forceinline__ unsigned ukey(float f) { const unsigned u = __float_as_uint(f); return (u & 0x80000000u) ? ~u : (u | 0x80000000u); }
__global__ void __launch_bounds__(512) k_dsa(P p) {
    __shared__ __attribute__((aligned(16))) float qi_s[8][64];
    __shared__ __attribute__((aligned(16))) float qd_s[8][64];
    __shared__ __attribute__((aligned(16))) float qabs[8][128];
    __shared__ float wi_s[8];
    __shared__ float sc[2048];
    __shared__ int idx[256];
    __shared__ int nsel_s;
    __shared__ int cntw[2][8];
    __shared__ float pb[8][256];
    __shared__ float oc[8][128];
    __shared__ float red[8];
    const float* cols = WS(float, W_COLS); const float* kiln = WS(float, W_KILN); const float* ckvn = WS(float, W_CKVN);
    const float* relb = p.in[18]; const float* w_uk = p.in[14]; const float* w_uv = p.in[15];
    const int tid = threadIdx.x, h = tid >> 6, lane = tid & 63;
    const float NINF = -INFINITY;
    for (int u = blockIdx.x; u < T_; u += gridDim.x) {
        const int b = u >> 11, t = u & 2047, n = t + 1;
        const float* crow = cols + (size_t)u * INC;
        __syncthreads();
        qi_s[h][lane] = crow[O_QI + h * 64 + lane]; qd_s[h][lane] = crow[O_QD + h * 64 + lane];
        if (tid < 8) wi_s[tid] = crow[O_WI + tid] * 0.044194173824159216f;
        if (tid == 0) nsel_s = 0;
        __syncthreads();
#pragma unroll 1
        for (int s = tid; s < n; s += 512) { const float* kp = kiln + (size_t)(b * 2048 + s) * 64; float4 kv[16];
#pragma unroll
            for (int i = 0; i < 16; ++i) kv[i] = ((const float4*)kp)[i];
            float acc = 0.f;
#pragma unroll 1
            for (int hh = 0; hh < 8; ++hh) { float d = 0.f;
#pragma unroll
                for (int i = 0; i < 16; ++i) { const float4 qv = ((const float4*)qi_s[hh])[i]; d += kv[i].x * qv.x + kv[i].y * qv.y + kv[i].z * qv.z + kv[i].w * qv.w; }
                acc += fmaxf(d, 0.f) * wi_s[hh]; }
            sc[s] = acc; }
#pragma unroll 1
        for (int i = 0; i < 2; ++i) { const int c = lane + 64 * i; qabs[h][c] = dot64(qd_s[h], w_uk + (size_t)(h * 128 + c) * 64); }
        __syncthreads();
        if (n <= 256) { if (tid < n) idx[tid] = tid; if (tid == 0) nsel_s = n; }
        else {
            unsigned kk[4]; bool kvld[4];
#pragma unroll
            for (int i = 0; i < 4; ++i) { const int s = tid + 512 * i; kvld[i] = s < n; kk[i] = kvld[i] ? ukey(sc[s]) : 0u; }
            unsigned prefix = 0u;
            for (int bit = 31; bit >= 0; --bit) { const unsigned cand = prefix | (1u << bit); int c = 0;
#pragma unroll
                for (int i = 0; i < 4; ++i) c += (kvld[i] && kk[i] >= cand) ? 1 : 0;
                c = wsumi(c); if (lane == 0) cntw[bit & 1][h] = c;
                __syncthreads();
                int tot = 0;
#pragma unroll
                for (int i = 0; i < 8; ++i) tot += cntw[bit & 1][i];
                if (tot >= 256) prefix = cand; }
            __syncthreads();
            int cg = 0;
#pragma unroll
            for (int i = 0; i < 4; ++i) cg += (kvld[i] && kk[i] > prefix) ? 1 : 0;
            cg = wsumi(cg); if (lane == 0) cntw[0][h] = cg;
            __syncthreads();
            int cgt = 0;
#pragma unroll
            for (int i = 0; i < 8; ++i) cgt += cntw[0][i];
            const int need = 256 - cgt;
#pragma unroll
            for (int i = 0; i < 4; ++i) if (kvld[i]) { const int s = tid + 512 * i; bool sel = kk[i] > prefix;
                if (kk[i] == prefix) { int rk = 0; for (int s2 = 0; s2 < s; ++s2) rk += (ukey(sc[s2]) == prefix) ? 1 : 0; sel = rk < need; }
                if (sel) { const int pos = atomicAdd(&nsel_s, 1); idx[pos] = s; } }
        }
        __syncthreads();
        const int nsel = nsel_s;
        float mx = NINF;
#pragma unroll 1
        for (int r = 0; r < 4; ++r) { const int i = lane + 64 * r; float l = NINF;
            if (i < nsel) { const int s = idx[i]; const float* cp = ckvn + (size_t)(b * 2048 + s) * 128;
                l = (dot64(qabs[h], cp) + dot64(qabs[h] + 64, cp + 64)) * 0.125f + relb[bucket(t - s) * 16 + 8 + h]; }
            pb[h][i] = l; mx = fmaxf(mx, l); }
        mx = wmax(mx);
        float sum = 0.f;
#pragma unroll 1
        for (int r = 0; r < 4; ++r) { const float l = pb[h][lane + 64 * r]; const float ee = (l > NINF) ? expf(l - mx) : 0.f; pb[h][lane + 64 * r] = ee; sum += ee; }
        sum = wsum(sum);
        const float inv = 1.f / sum;
        __syncthreads();
        float o0 = 0.f, o1 = 0.f;
#pragma unroll 4
        for (int i = 0; i < nsel; ++i) { const float pv = pb[h][i] * inv; const float* cp = ckvn + (size_t)(b * 2048 + idx[i]) * 128; o0 += pv * cp[lane]; o1 += pv * cp[64 + lane]; }
        oc[h][lane] = o0; oc[h][64 + lane] = o1;
        __syncthreads();
        float o = 0.f;
#pragma unroll 4
        for (int c = 0; c < 128; ++c) o += oc[h][c] * w_uv[(size_t)(h * 128 + c) * 64 + lane];
        const float ss = wsum(o * o);
        if (lane == 0) red[h] = ss;
        __syncthreads();
        float tot = 0.f;
#pragma unroll
        for (int i = 0; i < 8; ++i) tot += red[i];
        const float r = rsqrtf(tot * (1.f / 512.f) + 1e-6f);
        WS(float, W_MIX)[(size_t)u * 1024 + 512 + h * 64 + lane] = o * r * p.in[17][h * 64 + lane];
    }
}

struct EP_res { float* C; const float* x; const float* ada; int m0;
    __device__ __forceinline__ void operator()(int r, int col, float4 v, float4) const { const int row = m0 + r, b = row >> 11; const float4 xv = *(const float4*)(x + (size_t)row * 1024 + col);
        const float4 gv = *(const float4*)(ada + b * 6144 + 2048 + col);
        *(float4*)(C + (size_t)row * 1024 + col) = make_float4(ALPHA * xv.x + (1.f + gv.x) * v.x, ALPHA * xv.y + (1.f + gv.y) * v.y, ALPHA * xv.z + (1.f + gv.z) * v.z, ALPHA * xv.w + (1.f + gv.w) * v.w); } };
__global__ void __launch_bounds__(512) k_wout(P p) {
    __shared__ float lds[GEMM_LDS_FLOATS];
    const int m0 = blockIdx.y * 128, n0 = blockIdx.x * 128;
    AL_rows al{WS(float, W_MIX), 1024, m0, T_}; EP_res ep{p.out, p.in[0], WS(float, W_ADA), m0};
    gemm128<false>(al, p.in[19], nullptr, 1024, 1024, n0, 1024, ep, lds);
}

__global__ void __launch_bounds__(512) k_lnroute(P p) {
    __shared__ float hs[1024];
    __shared__ float red[16];
    __shared__ float part[16][32];
    __shared__ float lgt[32];
    const int tid = threadIdx.x, lane = tid & 63, w = tid >> 6;
    const float* ada = WS(float, W_ADA);
    for (int u = blockIdx.x; u < T_; u += gridDim.x) {
        const int b = u >> 11;
        float* zrow = p.out + (size_t)u * 1024;
        const float z0 = zrow[tid], z1 = zrow[tid + 512];
        __syncthreads();
        float s = wsum(z0 + z1); if (lane == 0) red[w] = s;
        __syncthreads();
        float mu = 0.f;
#pragma unroll
        for (int i = 0; i < 8; ++i) mu += red[i];
        mu *= (1.f / 1024.f);
        const float d0 = z0 - mu, d1 = z1 - mu;
        float q = wsum(d0 * d0 + d1 * d1); if (lane == 0) red[8 + w] = q;
        __syncthreads();
        float var = 0.f;
#pragma unroll
        for (int i = 0; i < 8; ++i) var += red[8 + i];
        const float rs = rsqrtf(var * (1.f / 1024.f) + 1e-5f);
        const float x0 = d0 * rs * p.in[20][tid] + p.in[21][tid], x1 = d1 * rs * p.in[20][tid + 512] + p.in[21][tid + 512];
        zrow[tid] = x0; zrow[tid + 512] = x1;
        const float h0 = x0 * (1.f + ada[b * 6144 + 4096 + tid]) + ada[b * 6144 + 3072 + tid];
        const float h1 = x1 * (1.f + ada[b * 6144 + 4096 + tid + 512]) + ada[b * 6144 + 3072 + tid + 512];
        float* h2 = WS(float, W_H2) + (size_t)u * 1024;
        h2[tid] = h0; h2[tid + 512] = h1; hs[tid] = h0; hs[tid + 512] = h1;
        __syncthreads();
        { const int e = tid & 31, pt = tid >> 5; float a = 0.f; const float* wr = p.in[22];
          for (int k = pt * 64; k < pt * 64 + 64; ++k) a += hs[k] * wr[k * 32 + e];
          part[pt][e] = a; }
        __syncthreads();
        if (tid < 32) { float a = p.in[23][tid];
#pragma unroll
            for (int i = 0; i < 16; ++i) a += part[i][tid];
            lgt[tid] = a; }
        __syncthreads();
        if (tid == 0) { int te[4]; float tv[4]; unsigned used = 0u;
#pragma unroll
            for (int k = 0; k < 4; ++k) { int best = -1; float bv = -INFINITY;
                for (int e = 0; e < 32; ++e) if (!((used >> e) & 1u) && (best < 0 || lgt[e] > bv)) { best = e; bv = lgt[e]; }
                used |= 1u << best; te[k] = best; tv[k] = bv; }
            const float m = tv[0]; float ex[4], sm = 0.f;
#pragma unroll
            for (int k = 0; k < 4; ++k) { ex[k] = expf(tv[k] - m); sm += ex[k]; }
            const int ch = u / CHT; int* cnt = WS(int, W_CNT) + ch * 32; int* list = WS(int, W_LIST) + (size_t)ch * 32 * (CHT * 4);
#pragma unroll
            for (int k = 0; k < 4; ++k) { WS(int, W_TOPE)[u * 4 + k] = te[k]; WS(float, W_TOPW)[u * 4 + k] = ex[k] / sm;
                const int pos = atomicAdd(cnt + te[k], 1); list[(size_t)te[k] * (CHT * 4) + pos] = (u - ch * CHT) * 4 + k; } }
    }
}

struct AL_gather { const float* A; const int* list; int nrows; int m0; int shift;
    __device__ __forceinline__ float4 load(int r, int k) const { const int m = m0 + r; if (m >= nrows) return make_float4(0.f, 0.f, 0.f, 0.f); return *(const float4*)(A + (size_t)(list[m] >> shift) * 1024 + k); } };
struct EP_act { float* C; const int* list; int nrows; int m0; const float* bg; const float* bu;
    __device__ __forceinline__ void operator()(int r, int col, float4 v, float4 v2) const { const int m = m0 + r; if (m >= nrows) return;
        const float gg[4] = {v.x, v.y, v.z, v.w}, uu[4] = {v2.x, v2.y, v2.z, v2.w}; float o[4];
#pragma unroll
        for (int i = 0; i < 4; ++i) { const float gt = fminf(gg[i] + bg[col + i], 7.f); const float up = fminf(fmaxf(uu[i] + bu[col + i], -7.f), 7.f); o[i] = gt * (1.f / (1.f + expf(-1.702f * gt))) * (up + 1.f); }
        *(float4*)(C + (size_t)list[m] * 1024 + col) = make_float4(o[0], o[1], o[2], o[3]); } };
__global__ void __launch_bounds__(512) k_gateup(P p, int ch) {
    __shared__ float lds[GEMM_LDS_FLOATS];
    const int e = blockIdx.z, m0 = blockIdx.y * 128, n0 = blockIdx.x * 128;
    const int nrows = WS(int, W_CNT)[ch * 32 + e]; if (m0 >= nrows) return;
    const int* list = WS(int, W_LIST) + ((size_t)ch * 32 + e) * (CHT * 4);
    AL_gather al{WS(float, W_H2) + (size_t)ch * CHT * 1024, list, nrows, m0, 2};
    EP_act ep{WS(float, W_ACT), list, nrows, m0, p.in[25] + e * 1024, p.in[27] + e * 1024};
    gemm128<true>(al, p.in[24] + (size_t)e * 1024 * 1024, p.in[26] + (size_t)e * 1024 * 1024, 1024, 1024, n0, 1024, ep, lds);
}
struct EP_down { float* C; const int* list; int nrows; int m0; const float* bd;
    __device__ __forceinline__ void operator()(int r, int col, float4 v, float4) const { const int m = m0 + r; if (m >= nrows) return;
        *(float4*)(C + (size_t)list[m] * 1024 + col) = make_float4(v.x + bd[col], v.y + bd[col + 1], v.z + bd[col + 2], v.w + bd[col + 3]); } };
__global__ void __launch_bounds__(512) k_down(P p, int ch) {
    __shared__ float lds[GEMM_LDS_FLOATS];
    const int e = blockIdx.z, m0 = blockIdx.y * 128, n0 = blockIdx.x * 128;
    const int nrows = WS(int, W_CNT)[ch * 32 + e]; if (m0 >= nrows) return;
    const int* list = WS(int, W_LIST) + ((size_t)ch * 32 + e) * (CHT * 4);
    AL_gather al{WS(float, W_ACT), list, nrows, m0, 0};
    EP_down ep{WS(float, W_YK), list, nrows, m0, p.in[29] + e * 1024};
    gemm128<false>(al, p.in[28] + (size_t)e * 1024 * 1024, nullptr, 1024, 1024, n0, 1024, ep, lds);
}

__global__ void __launch_bounds__(512) k_final(P p, int ch) {
    __shared__ float red[16];
    const int tid = threadIdx.x, lane = tid & 63, w = tid >> 6;
    const float* ada = WS(float, W_ADA);
    for (int ul = blockIdx.x; ul < CHT; ul += gridDim.x) {
        const int u = ch * CHT + ul, b = u >> 11;
        float* xrow = p.out + (size_t)u * 1024;
        const float* yk = WS(float, W_YK) + (size_t)ul * 4 * 1024;
        const float* tw = WS(float, W_TOPW) + u * 4;
        float y0 = 0.f, y1 = 0.f;
#pragma unroll
        for (int k = 0; k < 4; ++k) { y0 += tw[k] * yk[k * 1024 + tid]; y1 += tw[k] * yk[k * 1024 + tid + 512]; }
        const float z0 = ALPHA * xrow[tid] + (1.f + ada[b * 6144 + 5120 + tid]) * y0, z1 = ALPHA * xrow[tid + 512] + (1.f + ada[b * 6144 + 5120 + tid + 512]) * y1;
        __syncthreads();
        float s = wsum(z0 + z1); if (lane == 0) red[w] = s;
        __syncthreads();
        float mu = 0.f;
#pragma unroll
        for (int i = 0; i < 8; ++i) mu += red[i];
        mu *= (1.f / 1024.f);
        const float d0 = z0 - mu, d1 = z1 - mu;
        float q = wsum(d0 * d0 + d1 * d1); if (lane == 0) red[8 + w] = q;
        __syncthreads();
        float var = 0.f;
#pragma unroll
        for (int i = 0; i < 8; ++i) var += red[8 + i];
        const float rs = rsqrtf(var * (1.f / 1024.f) + 1e-5f);
        xrow[tid] = d0 * rs * p.in[30][tid] + p.in[31][tid];
        xrow[tid + 512] = d1 * rs * p.in[30][tid + 512] + p.in[31][tid + 512];
    }
}
}

extern "C" void kernel_launch(void* const* d_in, const int* in_sizes, int n_in, void* d_out, int out_size, void* d_ws, size_t ws_size, hipStream_t stream) {
    P p{};
    for (int i = 0; i < 32; ++i) p.in[i] = (const float*)d_in[i];
    p.out = (float*)d_out; p.ws = (unsigned char*)d_ws;
    (void)hipMemsetAsync(d_ws, 0, 4096, stream);
    k_ada<<<24, 256, 0, stream>>>(p);
    k_win<<<dim3(20, 256), 512, 0, stream>>>(p);
    k_cmp1<<<dim3(2, 32, 2), 512, 0, stream>>>(p);
    k_cmp2<<<dim3(1, 32, 2), 512, 0, stream>>>(p);
    k_prep<<<T_ / 4, 256, 0, stream>>>(p);
    k_nsa<<<T_, 512, 0, stream>>>(p);
    k_dsa<<<T_, 512, 0, stream>>>(p);
    k_wout<<<dim3(8, 256), 512, 0, stream>>>(p);
    k_lnroute<<<T_, 512, 0, stream>>>(p);
    for (int ch = 0; ch < NCHUNK; ++ch) {
        k_gateup<<<dim3(8, CHT * 4 / 128, 32), 512, 0, stream>>>(p, ch);
        k_down<<<dim3(8, CHT * 4 / 128, 32), 512, 0, stream>>>(p, ch);
        k_final<<<CHT, 512, 0, stream>>>(p, ch);
    }
}
```

```cpp
#include <hip/hip_runtime.h>
#include <stdint.h>
#include <cstdio>

namespace {
constexpr int B_ = 16, S_ = 2048, D_ = 1024, T_ = B_ * S_;
constexpr int INC = 2528;
constexpr int NCOL = 2560;
constexpr int O_GATE = 1280, O_QD = 1304;
constexpr int C_QN = 0, C_KC = 512, C_VC = 640, C_KS = 768, C_VS = 896, C_KW = 1024, C_VW = 1152, C_QD = 1280, C_CKV = 1792, C_QI = 1920, C_KI = 2432, C_GATE = 2496, C_WI = 2520;
constexpr int NC = 127, NCR = B_ * NC * 2;
constexpr int NCHUNK = 1, CHT = T_ / NCHUNK;
constexpr int MAXROWS = CHT * 4 + 32 * 256;
constexpr float ALPHA = 1.189207115002721f;
constexpr size_t MiB = 1u << 20;
constexpr size_t W_BAR = 0;
constexpr size_t W_CNT = 32768;
constexpr size_t W_ADA = 1 * MiB;
constexpr size_t W_TOPE = 2 * MiB, W_TOPW = 2 * MiB + 512 * 1024, W_POS = 3 * MiB, W_AROW = 3 * MiB + 512 * 1024;
constexpr size_t W_ROWTOK = 4 * MiB;
constexpr size_t W_SELM = 5 * MiB;
constexpr size_t W_WUKB = 5 * MiB + 256 * 1024;
constexpr size_t W_WUVT = 5 * MiB + 512 * 1024;
constexpr size_t W_BBASE = 5 * MiB + 768 * 1024;
constexpr size_t W_WOUTB = 6 * MiB;
constexpr size_t W_WINB = 8 * MiB;
constexpr size_t W_W1KB = 13 * MiB, W_W1VB = 14 * MiB;
constexpr size_t W_BIAS1 = 15 * MiB;
constexpr size_t W_W2T = 15 * MiB + 65536;
constexpr size_t W_WGU = 16 * MiB;
constexpr size_t W_WDN = 80 * MiB;
constexpr size_t W_COLS = 112 * MiB;
constexpr size_t W_KCVB = 272 * MiB;
constexpr size_t W_ONSA = 292 * MiB;
constexpr size_t W_YB = 292 * MiB;
constexpr size_t W_ODSA = 356 * MiB;
constexpr size_t W_HB = 356 * MiB;
constexpr size_t W_MIXB = 420 * MiB;
constexpr size_t W_DMASK = 484 * MiB;
constexpr size_t W_CKVN = 492 * MiB;
constexpr size_t W_KILN = 500 * MiB;
constexpr size_t W_KC = 504 * MiB, W_VC = 505 * MiB;
constexpr size_t W_H1B = 506 * MiB;
constexpr size_t W_H1K = 520 * MiB, W_H1V = 525 * MiB;
constexpr size_t W_QCTR = 49152;
constexpr size_t W_H2B = 112 * MiB;
constexpr size_t W_ACTB = 144 * MiB;
constexpr size_t W_X1B = 416 * MiB;
constexpr size_t W_YPB = 280 * MiB;

__constant__ unsigned char c_bucket[128] = {
    0, 1, 2, 3, 4, 5, 6, 7, 8, 9, 10, 11, 12, 13, 14, 15, 16, 16, 16, 17, 17, 18, 18, 18, 19, 19, 19, 20, 20, 20, 20, 21,
    21, 21, 21, 22, 22, 22, 22, 22, 23, 23, 23, 23, 23, 23, 24, 24, 24, 24, 24, 24, 25, 25, 25, 25, 25, 25, 25, 26, 26, 26, 26, 26,
    26, 26, 26, 27, 27, 27, 27, 27, 27, 27, 27, 27, 27, 28, 28, 28, 28, 28, 28, 28, 28, 28, 28, 29, 29, 29, 29, 29, 29, 29, 29, 29,
    29, 29, 29, 30, 30, 30, 30, 30, 30, 30, 30, 30, 30, 30, 30, 30, 30, 31, 31, 31, 31, 31, 31, 31, 31, 31, 31, 31, 31, 31, 31, 31};
__device__ __forceinline__ int bucket(int d) { return d >= 128 ? 31 : (int)c_bucket[d]; }

__device__ __forceinline__ float dppf(float v, const int ctrl_unused) { return v; }
__device__ __forceinline__ float wsum(float v) {
    v += __builtin_bit_cast(float, __builtin_amdgcn_update_dpp(0, __builtin_bit_cast(int, v), 0xB1, 0xF, 0xF, false));
    v += __builtin_bit_cast(float, __builtin_amdgcn_update_dpp(0, __builtin_bit_cast(int, v), 0x4E, 0xF, 0xF, false));
    v += __builtin_bit_cast(float, __builtin_amdgcn_update_dpp(0, __builtin_bit_cast(int, v), 0x141, 0xF, 0xF, false));
    v += __builtin_bit_cast(float, __builtin_amdgcn_update_dpp(0, __builtin_bit_cast(int, v), 0x140, 0xF, 0xF, false));
    const int iv = __builtin_bit_cast(int, v);
    return (__builtin_bit_cast(float, __builtin_amdgcn_readlane(iv, 0)) + __builtin_bit_cast(float, __builtin_amdgcn_readlane(iv, 16))) + (__builtin_bit_cast(float, __builtin_amdgcn_readlane(iv, 32)) + __builtin_bit_cast(float, __builtin_amdgcn_readlane(iv, 48)));
}
__device__ __forceinline__ float wmax(float v) { for (int o = 32; o > 0; o >>= 1) v = fmaxf(v, __shfl_xor(v, o)); return v; }
__device__ __forceinline__ int wsumi(int v) { for (int o = 32; o > 0; o >>= 1) v += __shfl_xor(v, o); return v; }

typedef unsigned short bf16_t;
__device__ __forceinline__ unsigned f2bf(float f) { unsigned u = __float_as_uint(f); return (u + 0x7fffu + ((u >> 16) & 1u)) >> 16; }
__device__ __forceinline__ unsigned pk2(float lo, float hi) { return f2bf(lo) | (f2bf(hi) << 16); }
__device__ __forceinline__ float bf2f(unsigned short v) { return __uint_as_float((unsigned)v << 16); }
__device__ __forceinline__ unsigned pk4_fp8(float a, float b, float c, float d) { int v = __builtin_amdgcn_cvt_pk_fp8_f32(a, b, 0, false); v = __builtin_amdgcn_cvt_pk_fp8_f32(c, d, v, true); return (unsigned)v; }
__device__ __forceinline__ float blo(unsigned v) { return __uint_as_float(v << 16); }
__device__ __forceinline__ float bhi(unsigned v) { return __uint_as_float(v & 0xffff0000u); }

struct P {
    const float* in[32];
    float* out;
    unsigned char* ws;
};
#define WS(T, off) ((T*)(p.ws + (off)))

namespace pg8 {
#define PG8_LAS __attribute__((address_space(3)))
typedef unsigned short bf16_t;
typedef short bf16x8 __attribute__((ext_vector_type(8)));
typedef float f32x4 __attribute__((ext_vector_type(4)));
typedef float f32x2 __attribute__((ext_vector_type(2)));
typedef unsigned u32x4 __attribute__((ext_vector_type(4)));
typedef int i32x4 __attribute__((ext_vector_type(4)));
typedef int i32x8 __attribute__((ext_vector_type(8)));
constexpr int BM = 256, BK = 64, HALF = 128, HTB = HALF * BK * 2, STAGE_BYTES = 8 * HTB;
__device__ __forceinline__ int lds_byte(int r, int c) { const int st = (r >> 4) * 2 + (c >> 5), rr = r & 15, cc = c & 31, ob = rr * 64 + cc * 2; return st * 1024 + (ob ^ (((ob >> 9) & 1) << 5)); }
__device__ __forceinline__ void stage_rc(int b, int& R, int& C) { const int st = b / 1024, sb = b % 1024, swz = sb ^ (((sb >> 9) & 1) << 5); R = (st >> 1) * 16 + swz / 64; C = (st & 1) * 32 + (swz % 64) / 2; }
__device__ __forceinline__ int perm32(int rho) { const int n = rho >> 4, i = rho & 15; return 8 * (i >> 2) + 4 * n + (i & 3); }
struct Unit { int pm, pn; };
struct Gemm { const bf16_t* A; const bf16_t* Bt; int K; };
__device__ __forceinline__ unsigned cvt_pk_bf16(float lo, float hi) { unsigned r; asm volatile("v_cvt_pk_bf16_f32 %0, %1, %2" : "=v"(r) : "v"(lo), "v"(hi)); return r; }
struct RowsDense { static constexpr bool DENSE = true; unsigned pitch;
    __device__ __forceinline__ unsigned off(int pm, int r) const { return (unsigned)(pm * BM + r) * pitch; } };
struct RowsDenseL { static constexpr bool DENSE = false; unsigned pitch;
    __device__ __forceinline__ unsigned off(int pm, int r) const { return (unsigned)(pm * BM + r) * pitch; } };
struct RowsGather { static constexpr bool DENSE = false; const int* rowtok; unsigned pitch;
    __device__ __forceinline__ unsigned off(int pm, int r) const { return (unsigned)rowtok[pm * BM + r] * pitch; } };

template <class Epi, class Sched, class AMap, bool ALIGN_EPI, int MK = 0  >
__device__ __forceinline__ void gemm_phase(PG8_LAS unsigned char* lds, const Gemm g, const Sched& S, const Epi& E, const AMap& AM) {
    int tid_ = threadIdx.x; asm volatile("" : "+v"(tid_));
    const int tid = tid_, wid = __builtin_amdgcn_readfirstlane(tid >> 6), lane = tid & 63, wr = wid >> 2, wc = wid & 3, fr = lane & 15, fq = lane >> 4;
    const int K = g.K, nt = K / BK;
    unsigned voffB[2], ca2[2]; int ra[2];
#pragma unroll
    for (int i = 0; i < 2; ++i) { int R, C; stage_rc(tid * 16 + i * 8192, R, C); const int Rb = Epi::PERM ? ((R & ~31) + perm32(R & 31)) : R;
        ra[i] = R; ca2[i] = (unsigned)C * 2u; voffB[i] = (unsigned)(Rb * K + C) * 2u; }
    const size_t kstep = (size_t)(BK * 2);
    const size_t hstep = (size_t)HALF * K * 2;
    const size_t tstep = 2 * hstep;
    const unsigned ldsw = (unsigned)wid * 1024u;
    const int aoff = lds_byte(wr * 64 + fr, fq * 8), boff = lds_byte(wc * 32 + fr, fq * 8);
    const char* Ab = (const char*)g.A;
#define PG8_SA(b, h) (((b) * 2 + (h)) * HTB)
#define PG8_SB(b, h) ((4 + (b) * 2 + (h)) * HTB)
#define PG8_STAGE(bufoff, gbase, voff) do { _Pragma("unroll") for (int _i = 0; _i < 2; ++_i) \
        __builtin_amdgcn_global_load_lds((const unsigned*)((const char*)(gbase) + (voff)[_i]), (PG8_LAS unsigned*)(lds + (bufoff) + ldsw + _i * 8192), 16, 0, 0); } while (0)
#define PG8_LDA(dst, b, h) do { _Pragma("unroll") for (int m = 0; m < 4; ++m) _Pragma("unroll") for (int k = 0; k < 2; ++k) dst[m][k] = *(const PG8_LAS bf16x8*)(lds + PG8_SA(b, h) + aoff + m * 2048 + k * 1024); } while (0)
#define PG8_LDB(dst, b, h) do { _Pragma("unroll") for (int n = 0; n < 2; ++n) _Pragma("unroll") for (int k = 0; k < 2; ++k) dst[n][k] = *(const PG8_LAS bf16x8*)(lds + PG8_SB(b, h) + boff + n * 2048 + k * 1024); } while (0)
#define PG8_MMA(ai, bj, At, Bt) do { __builtin_amdgcn_s_setprio(1); _Pragma("unroll") for (int m = 0; m < 4; ++m) _Pragma("unroll") for (int n = 0; n < 2; ++n) { \
        if constexpr (MK == 0) { _Pragma("unroll") for (int k = 0; k < 2; ++k) acc[ai][bj][m][n] = __builtin_amdgcn_mfma_f32_16x16x32_bf16(Bt[n][k], At[m][k], acc[ai][bj][m][n], 0, 0, 0); } \
        else { const i32x8 b8_ = __builtin_shufflevector(__builtin_bit_cast(i32x4, Bt[n][0]), __builtin_bit_cast(i32x4, Bt[n][1]), 0, 1, 2, 3, 4, 5, 6, 7); \
               const i32x8 a8_ = __builtin_shufflevector(__builtin_bit_cast(i32x4, At[m][0]), __builtin_bit_cast(i32x4, At[m][1]), 0, 1, 2, 3, 4, 5, 6, 7); \
               acc[ai][bj][m][n] = __builtin_amdgcn_mfma_scale_f32_16x16x128_f8f6f4(b8_, a8_, acc[ai][bj][m][n], 0, 0, 0, 0x7f7f7f7f, 0, 0x7f7f7f7f); } } \
        __builtin_amdgcn_s_setprio(0); } while (0)
#define PG8_WAIT_V(n) asm volatile("s_waitcnt vmcnt(" #n ")" ::: "memory")
#define PG8_WAIT_L(n) asm volatile("s_waitcnt lgkmcnt(" #n ")" ::: "memory")
#define PG8_BAR __builtin_amdgcn_s_barrier()
#define PG8_SCHED __builtin_amdgcn_sched_barrier(0)
    Unit cur, nxt; int ui = 0;
    if (!S.next(0, cur)) return;
#define PG8_WAIT_V1() do { if constexpr (Epi::NSTORE == 16) asm volatile("s_waitcnt vmcnt(24)\n\ts_cmp_lg_u32 %0, 0\n\ts_cbranch_scc1 1f\n\ts_waitcnt vmcnt(8)\n1:" :: "s"(fe) : "memory", "scc"); \
        else if constexpr (Epi::NSTORE == 8) asm volatile("s_waitcnt vmcnt(16)\n\ts_cmp_lg_u32 %0, 0\n\ts_cbranch_scc1 1f\n\ts_waitcnt vmcnt(8)\n1:" :: "s"(fe) : "memory", "scc"); \
        else asm volatile("s_waitcnt vmcnt(8)" ::: "memory"); } while (0)
    int after_epi = 0;
    f32x4 acc[2][2][4][2];
#pragma unroll
    for (int a = 0; a < 2; ++a)
#pragma unroll
        for (int b = 0; b < 2; ++b)
#pragma unroll
            for (int m = 0; m < 4; ++m)
#pragma unroll
                for (int n = 0; n < 2; ++n) acc[a][b][m][n] = (f32x4){0.f, 0.f, 0.f, 0.f};
    bf16x8 At[4][2], B0[2][2], B1[2][2];
    unsigned ov0[2], ov1[2], nv0[2], nv1[2];
    const char* uA = Ab; const char* nA = Ab;
    if constexpr (AMap::DENSE) {
#pragma unroll
        for (int i = 0; i < 2; ++i) { ov0[i] = AM.off(0, ra[i]) + ca2[i]; ov1[i] = AM.off(0, HALF + ra[i]) + ca2[i]; }
        uA = Ab + (size_t)AM.off(cur.pm, 0);
    } else {
#pragma unroll
        for (int i = 0; i < 2; ++i) { ov0[i] = AM.off(cur.pm, ra[i]) + ca2[i]; ov1[i] = AM.off(cur.pm, HALF + ra[i]) + ca2[i]; }
    }
    const char* cB = (const char*)g.Bt + (size_t)cur.pn * tstep;
    S.a_ready(cur);
    PG8_STAGE(PG8_SB(0, 0), cB, voffB); PG8_STAGE(PG8_SB(0, 1), cB + hstep, voffB); PG8_STAGE(PG8_SA(0, 0), uA, ov0); PG8_STAGE(PG8_SA(0, 1), uA, ov1);
    if (wr == 1) PG8_BAR;
    PG8_WAIT_V(2); PG8_BAR;
    PG8_STAGE(PG8_SB(1, 0), cB + kstep, voffB); PG8_STAGE(PG8_SA(1, 0), uA + kstep, ov0); PG8_STAGE(PG8_SB(1, 1), cB + hstep + kstep, voffB);
    PG8_WAIT_V(6); PG8_BAR;
    PG8_STAGE(PG8_SA(1, 1), uA + kstep, ov1);
    for (;;) {
        const bool has_next = S.next(ui + 1, nxt);
        const char* nB = has_next ? (const char*)g.Bt + (size_t)nxt.pn * tstep : cB;
        if constexpr (AMap::DENSE) { nA = has_next ? Ab + (size_t)AM.off(nxt.pm, 0) : uA; }
        else {
#pragma unroll
            for (int i = 0; i < 2; ++i) { nv0[i] = has_next ? AM.off(nxt.pm, ra[i]) + ca2[i] : ov0[i]; nv1[i] = has_next ? AM.off(nxt.pm, HALF + ra[i]) + ca2[i] : ov1[i]; }
        }
#pragma unroll 1
        for (int t = 0; t < nt; t += 2) {
            const bool last = (t == nt - 2);
            const int fe = __builtin_amdgcn_readfirstlane(t == 0 ? after_epi : 0);
            const char* a1 = uA + (size_t)(t + 1) * kstep;
            const char* a2 = last ? nA : uA + (size_t)(t + 2) * kstep; const char* b2 = last ? nB : cB + (size_t)(t + 2) * kstep;
            const char* a3 = a2 + kstep; const char* b3 = b2 + kstep;
            if (last && has_next) S.a_ready(nxt);
            PG8_LDB(B0, 0, 0); PG8_LDB(B1, 0, 1); PG8_SCHED; PG8_LDA(At, 0, 0);
            if constexpr (!AMap::DENSE) { if (last) {
_Pragma("unroll") for (int i = 0; i < 2; ++i) { ov0[i] = nv0[i]; ov1[i] = nv1[i]; } } }
            PG8_WAIT_V1(); PG8_WAIT_L(0); PG8_BAR; PG8_MMA(0, 0, At, B0); PG8_MMA(0, 1, At, B1); PG8_BAR; PG8_SCHED;
            PG8_LDA(At, 0, 1); PG8_STAGE(PG8_SB(0, 0), b2, voffB); PG8_STAGE(PG8_SB(0, 1), b2 + hstep, voffB); PG8_STAGE(PG8_SA(0, 0), a2, ov0);
            PG8_WAIT_V1(); PG8_WAIT_L(0); PG8_BAR; PG8_MMA(1, 0, At, B0); PG8_MMA(1, 1, At, B1); PG8_BAR; PG8_SCHED;
            PG8_LDB(B0, 1, 0); PG8_LDB(B1, 1, 1); PG8_SCHED; PG8_LDA(At, 1, 0); PG8_STAGE(PG8_SA(0, 1), a2, ov1);
            PG8_WAIT_V1(); PG8_WAIT_L(0); PG8_BAR; PG8_MMA(0, 0, At, B0); PG8_MMA(0, 1, At, B1); PG8_BAR; PG8_SCHED;
            PG8_LDA(At, 1, 1); PG8_STAGE(PG8_SB(1, 0), b3, voffB); PG8_STAGE(PG8_SB(1, 1), b3 + hstep, voffB); PG8_STAGE(PG8_SA(1, 0), a3, ov0);
            PG8_WAIT_V(8); PG8_WAIT_L(0); PG8_BAR; PG8_MMA(1, 0, At, B0); PG8_MMA(1, 1, At, B1); PG8_BAR; PG8_SCHED;
            PG8_STAGE(PG8_SA(1, 1), a3, ov1);
        }
        after_epi = 1;
        if constexpr (ALIGN_EPI) { if (wr == 0) PG8_BAR; }
        E(acc, cur, wr, wc, fr, fq); S.done(cur);
        if (!has_next) break;
#pragma unroll
        for (int a = 0; a < 2; ++a)
#pragma unroll
            for (int b = 0; b < 2; ++b)
#pragma unroll
                for (int m = 0; m < 4; ++m)
#pragma unroll
                    for (int n = 0; n < 2; ++n) acc[a][b][m][n] = (f32x4){0.f, 0.f, 0.f, 0.f};
        cur = nxt; cB = nB; uA = nA; ++ui;
        if constexpr (ALIGN_EPI) { if (wr == 1) PG8_BAR; }
    }
    PG8_WAIT_V(0);
    if constexpr (!ALIGN_EPI) { if (wr == 0) PG8_BAR; }
    PG8_BAR;
#undef PG8_SA
#undef PG8_SB
#undef PG8_STAGE
#undef PG8_LDA
#undef PG8_LDB
#undef PG8_MMA
#undef PG8_WAIT_V
#undef PG8_WAIT_V1
#undef PG8_WAIT_L
#undef PG8_BAR
#undef PG8_SCHED
}
}

#define XB_TMO      128
#define XB_XCNT(j)  (256  + 64 * (j))
#define XB_XSUB(j)  (1280 + 64 * (j))
#define XB_XGEN(j)  (2304 + 64 * (j))
#define XB_TOP      3328
#define XB_TOPGEN   3392
#define XCD_BAR_WORDS 3456
#define XB_SPIN_CAP (1u << 18)
#define LAS __attribute__((address_space(3)))
__device__ __forceinline__ unsigned xb_ld(unsigned* p)              { return __hip_atomic_load(p, __ATOMIC_RELAXED, __HIP_MEMORY_SCOPE_AGENT); }
__device__ __forceinline__ unsigned xb_add(unsigned* p, unsigned v) { return __hip_atomic_fetch_add(p, v, __ATOMIC_RELAXED, __HIP_MEMORY_SCOPE_AGENT); }
__device__ __forceinline__ unsigned xb_xcc_id() { return (unsigned)__builtin_amdgcn_s_getreg((3 << 11) | 20) & 0xFu; }
#define XB_SPIN(cond, bar) do { unsigned _sp = 0; while (cond) { __builtin_amdgcn_s_sleep(1); \
    if ((++_sp & 255u) == 0u) { if (xb_ld(&(bar)[XB_TMO])) break; if (_sp > XB_SPIN_CAP) { atomicAdd(&(bar)[XB_TMO], 1u); break; } } } } while (0)
struct XcdBarrier { unsigned* bar; unsigned x; volatile LAS unsigned* st; };
__device__ __forceinline__ XcdBarrier xcd_barrier_post(unsigned* bar, volatile LAS unsigned* st) {
    XcdBarrier b; b.bar = bar; b.x = xb_xcc_id(); b.st = st;
    if (threadIdx.x == 0) (void)xb_add(&bar[XB_XCNT(b.x)], 1u);
    return b;
}
__device__ __forceinline__ void xcd_barrier_complete(unsigned* bar, unsigned x, unsigned& nloc, unsigned& nx) {
    const unsigned G = gridDim.x * gridDim.y * gridDim.z;
    unsigned sum, cnt, mine, sp = 0u;
    for (;;) {
        sum = 0u; cnt = 0u; mine = 0u;
#pragma unroll
        for (unsigned j = 0; j < 16; ++j) { const unsigned c = xb_ld(&bar[XB_XCNT(j)]); sum += c; cnt += (c > 0u) ? 1u : 0u; mine = (j == x) ? c : mine; }
        if (sum == G) break;
        __builtin_amdgcn_s_sleep(1);
        if ((++sp & 255u) == 0u) { if (xb_ld(&bar[XB_TMO])) break; if (sp > XB_SPIN_CAP) { atomicAdd(&bar[XB_TMO], 1u); break; } }
    }
    nloc = mine > 0u ? mine : 1u; nx = cnt > 0u ? cnt : 1u;
}
__device__ __forceinline__ void xcd_barrier(const XcdBarrier& b) {
    asm volatile("s_waitcnt vmcnt(0)" ::: "memory");
    __syncthreads();
    if (threadIdx.x == 0) {
        unsigned* bar = b.bar;
        __builtin_amdgcn_s_waitcnt(0);
        unsigned nloc = b.st[0], nx = b.st[1];
        if (nloc == 0u) { xcd_barrier_complete(bar, b.x, nloc, nx); b.st[0] = nloc; b.st[1] = nx; }
        const unsigned old = xb_add(&bar[XB_XSUB(b.x)], 1u);
        const unsigned gen = old / nloc;
        if (old + 1u == (gen + 1u) * nloc) {
            __builtin_amdgcn_fence(__ATOMIC_RELEASE, "agent");
            asm volatile("s_waitcnt vmcnt(0)" ::: "memory");
            const unsigned og = xb_add(&bar[XB_TOP], 1u);
            const unsigned tg = og / nx;
            if (og + 1u == (tg + 1u) * nx) xb_add(&bar[XB_TOPGEN], 1u);
            else XB_SPIN(xb_ld(&bar[XB_TOPGEN]) == tg, bar);
            __builtin_amdgcn_fence(__ATOMIC_ACQUIRE, "agent");
            xb_add(&bar[XB_XGEN(b.x)], 1u);
            asm volatile("s_waitcnt vmcnt(0)" ::: "memory");
        } else {
            XB_SPIN(xb_ld(&bar[XB_XGEN(b.x)]) == gen, bar);
            __builtin_amdgcn_fence(__ATOMIC_ACQUIRE, "agent");
            asm volatile("s_waitcnt vmcnt(0)" ::: "memory");
        }
    }
    __syncthreads();
}

template <class RowMap>
__device__ __forceinline__ void transpose_item(const float* W, int ldw, int K, bf16_t* WT, const RowMap& rm, float* scr, int kb, int nb, int lane) {
    const int k0 = 64 * kb, n0 = 32 * nb;
#pragma unroll 8
    for (int i = 0; i < 32; ++i) { const int kk = 2 * i + (lane >> 5); scr[kk * 33 + (lane & 31)] = W[(size_t)(k0 + kk) * ldw + n0 + (lane & 31)]; }
    __builtin_amdgcn_fence(__ATOMIC_RELEASE, "wavefront"); asm volatile("s_waitcnt lgkmcnt(0)" ::: "memory");
    const int c = lane & 7;
#pragma unroll
    for (int j = 0; j < 4; ++j) { const int n = (lane >> 3) + 8 * j; const float* s = scr + (8 * c) * 33 + n;
        uint4 o; o.x = pk2(s[0 * 33], s[1 * 33]); o.y = pk2(s[2 * 33], s[3 * 33]); o.z = pk2(s[4 * 33], s[5 * 33]); o.w = pk2(s[6 * 33], s[7 * 33]);
        *(uint4*)(WT + (size_t)rm(n0 + n) * K + k0 + 8 * c) = o; }
    asm volatile("s_waitcnt lgkmcnt(0)" ::: "memory");
}
struct RM_ident { int off; __device__ __forceinline__ int operator()(int n) const { return off + n; } };
struct RM_gu { int mtx; __device__ __forceinline__ int operator()(int f) const { return (f >> 7) * 256 + mtx * 128 + (f & 127); } };
struct RM_win { __device__ __forceinline__ int operator()(int n) const { return n < O_GATE ? n : (n < O_QD ? C_GATE + (n - O_GATE) : (n < 2520 ? n - 24 : n)); } };

constexpr float WSCALE = 64.f, WSCALE_INV = 1.f / 64.f;
template <class RowMap>
__device__ __forceinline__ void transpose_item_f8(const float* W, int ldw, int K, unsigned char* WT, const RowMap& rm, float* scr, int kb, int nb, int lane) {
    const int k0 = 64 * kb, n0 = 32 * nb;
    float wv[32];
#pragma unroll
    for (int i = 0; i < 32; ++i) wv[i] = W[(size_t)(k0 + 2 * i + (lane >> 5)) * ldw + n0 + (lane & 31)];
#pragma unroll
    for (int i = 0; i < 32; ++i) scr[(2 * i + (lane >> 5)) * 33 + (lane & 31)] = wv[i] * WSCALE;
    __builtin_amdgcn_fence(__ATOMIC_RELEASE, "wavefront"); asm volatile("s_waitcnt lgkmcnt(0)" ::: "memory");
    const int n = lane >> 1, hf = lane & 1; const float* s = scr + (32 * hf) * 33 + n;
    uint4 o0, o1;
    o0.x = pk4_fp8(s[0 * 33], s[1 * 33], s[2 * 33], s[3 * 33]);     o0.y = pk4_fp8(s[4 * 33], s[5 * 33], s[6 * 33], s[7 * 33]);
    o0.z = pk4_fp8(s[8 * 33], s[9 * 33], s[10 * 33], s[11 * 33]);   o0.w = pk4_fp8(s[12 * 33], s[13 * 33], s[14 * 33], s[15 * 33]);
    o1.x = pk4_fp8(s[16 * 33], s[17 * 33], s[18 * 33], s[19 * 33]); o1.y = pk4_fp8(s[20 * 33], s[21 * 33], s[22 * 33], s[23 * 33]);
    o1.z = pk4_fp8(s[24 * 33], s[25 * 33], s[26 * 33], s[27 * 33]); o1.w = pk4_fp8(s[28 * 33], s[29 * 33], s[30 * 33], s[31 * 33]);
    uint4* d = (uint4*)(WT + (size_t)rm(n0 + n) * K + k0 + 32 * hf); d[0] = o0; d[1] = o1;
    asm volatile("s_waitcnt lgkmcnt(0)" ::: "memory");
}
__device__ __forceinline__ void ph_pre(const P& p, char* lds) {
    { const int lane = threadIdx.x & 63, wave = threadIdx.x >> 6;
      float* scr = (float*)(lds + 32768 + wave * 8704);
      const int gw = ((int)gridDim.x - 1 - (int)blockIdx.x) * 8 + wave, NGW = gridDim.x * 8;
      constexpr int I_IN = 16 * 79, I_OUT = 16 * 32, I_W1 = 32 * 8;
      for (int it = gw; it < I_IN + I_OUT + 32 + 2 * I_W1; it += NGW) {
          if (it >= I_IN + I_OUT + 32) { const int r = it - (I_IN + I_OUT + 32), kv = r / I_W1, q = r % I_W1; transpose_item(p.in[kv ? 9 : 6], 256, 2048, WS(bf16_t, kv ? W_W1VB : W_W1KB), RM_ident{0}, scr, q >> 3, q & 7, lane); continue; }
          if (it < I_IN) transpose_item(p.in[4], INC, 1024, WS(bf16_t, W_WINB), RM_win{}, scr, it / 79, it % 79, lane);
          else if (it < I_IN + I_OUT) { const int r = it - I_IN; transpose_item_f8(p.in[19], 1024, 1024, WS(unsigned char, W_WOUTB), RM_ident{0}, scr, r >> 5, r & 31, lane); }
          else { const int r = it - I_IN - I_OUT; uint4* z = (uint4*)(WS(bf16_t, W_WINB) + (size_t)(INC + r) * 1024); z[lane] = make_uint4(0u, 0u, 0u, 0u); z[lane + 64] = make_uint4(0u, 0u, 0u, 0u); } } }
    if (blockIdx.x == gridDim.x - 1) { const int kv = threadIdx.x >> 8, n = threadIdx.x & 255; const float* w1 = p.in[kv ? 9 : 6]; const float* pos = p.in[kv ? 8 : 5]; float a = 0.f;
        for (int k = 0; k < 2048; ++k) a += pos[k] * w1[(size_t)k * 256 + n];
        WS(float, W_BIAS1)[kv * 256 + n] = a; }
    for (int i = blockIdx.x * 512 + threadIdx.x; i < 2 * 64 * 256; i += gridDim.x * 512) { const int kv = i >> 14, n = (i >> 8) & 63, k = i & 255; WS(bf16_t, W_W2T)[i] = (bf16_t)f2bf(p.in[kv ? 10 : 7][k * 64 + n]); }
    for (int i = blockIdx.x * 512 + threadIdx.x; i < 65536; i += gridDim.x * 512) { WS(bf16_t, W_WUKB)[i] = (bf16_t)f2bf(p.in[14][i]);
        const int hh = i >> 13, d = (i >> 7) & 63, c = i & 127; WS(bf16_t, W_WUVT)[i] = (bf16_t)f2bf(p.in[15][(size_t)(hh * 128 + c) * 64 + d]); }
    if (blockIdx.x < 96) {
        float* sl = (float*)lds;
        float* red = (float*)(lds + 65536);
        const int tid = threadIdx.x, jl = tid & 63, kg = tid >> 6;
        __syncthreads();
        for (int i = tid; i < 16384; i += 512) { const int b = i >> 10, k = i & 1023; const float v = p.in[1][i]; sl[k * 16 + b] = v / (1.f + expf(-v)); }
        __syncthreads();
        for (int u = blockIdx.x; u < 96; u += gridDim.x) {
            const int j = u * 64 + jl; const float* w = p.in[2] + j;
            float acc[16];
#pragma unroll
            for (int b = 0; b < 16; ++b) acc[b] = 0.f;
#pragma unroll 8
            for (int k = kg * 128; k < kg * 128 + 128; ++k) { const float wv = w[(size_t)k * 6144]; const float4* s4 = (const float4*)(sl + k * 16);
                const float4 s0 = s4[0], s1 = s4[1], s2 = s4[2], s3 = s4[3];
                acc[0] += s0.x * wv; acc[1] += s0.y * wv; acc[2] += s0.z * wv; acc[3] += s0.w * wv; acc[4] += s1.x * wv; acc[5] += s1.y * wv; acc[6] += s1.z * wv; acc[7] += s1.w * wv;
                acc[8] += s2.x * wv; acc[9] += s2.y * wv; acc[10] += s2.z * wv; acc[11] += s2.w * wv; acc[12] += s3.x * wv; acc[13] += s3.y * wv; acc[14] += s3.z * wv; acc[15] += s3.w * wv; }
#pragma unroll
            for (int b = 0; b < 16; ++b) red[(kg * 16 + b) * 64 + jl] = acc[b];
            __syncthreads();
            for (int o = tid; o < 1024; o += 512) { const int b = o >> 6, jj = o & 63; float a = p.in[3][u * 64 + jj];
#pragma unroll
                for (int g8 = 0; g8 < 8; ++g8) a += red[(g8 * 16 + b) * 64 + jj];
                WS(float, W_ADA)[b * 6144 + u * 64 + jj] = a; }
            __syncthreads();
        }
    }
}
__device__ __forceinline__ void ph_hmod(const P& p) {
    const int lane = threadIdx.x & 63; const float* ada = WS(float, W_ADA);
#pragma unroll 2
    for (int u = blockIdx.x * 8 + (threadIdx.x >> 6); u < T_; u += gridDim.x * 8) {
        const int b = u >> 11; const float* xr = p.in[0] + (size_t)u * 1024; bf16_t* hr = WS(bf16_t, W_HB) + (size_t)u * 1024;
#pragma unroll
        for (int j = 0; j < 4; ++j) { const int c = j * 256 + lane * 4; const float4 xv = *(const float4*)(xr + c), sh = *(const float4*)(ada + b * 6144 + c), sc = *(const float4*)(ada + b * 6144 + 1024 + c);
            uint2 o; o.x = pk2(xv.x * (1.f + sc.x) + sh.x, xv.y * (1.f + sc.y) + sh.y); o.y = pk2(xv.z * (1.f + sc.z) + sh.z, xv.w * (1.f + sc.w) + sh.w);
            *(uint2*)(hr + c) = o; }
    }
}
struct StaticOrder {
    int nM, nN, nwg, G, c;
    __device__ __forceinline__ void init(int M, int N, int G_, int c_) { nM = M / 256; nN = N / 256; nwg = nM * nN; G = G_; c = c_; }
    __device__ __forceinline__ bool next(int i, pg8::Unit& u) const {
        const long L = (long)i * G + c; if (L >= nwg) return false;
        int wgid = (int)L; { const int q = nwg / 8, r = nwg % 8, xcd = wgid % 8, off = wgid / 8; wgid = (xcd < r ? xcd * (q + 1) : r * (q + 1) + (xcd - r) * q) + off; }
        const int nig = 8 * nN, gid = wgid / nig, fm = gid * 8, gsz = (nM - fm) < 8 ? (nM - fm) : 8;
        u.pm = fm + ((wgid % nig) % gsz); u.pn = (wgid % nig) / gsz; return true;
    }
    __device__ __forceinline__ void a_ready(const pg8::Unit&) const {}
    __device__ __forceinline__ void done(const pg8::Unit&) const {}
};
struct EpiCols { static constexpr bool PERM = true; static constexpr int NSTORE = 16;
    bf16_t* O; bf16_t* KCV;
    __device__ __forceinline__ void operator()(const pg8::f32x4 (&acc)[2][2][4][2], const pg8::Unit& u, int wr, int wc, int fr, int fq) const {
        const int row0 = u.pm * 256 + wr * 64 + fr;
        const float qs = (u.pn == 0 || u.pn == 1 || u.pn == 5 || u.pn == 6) ? 0.125f * 1.4426950408889634f : 1.f;
#pragma unroll
        for (int ai = 0; ai < 2; ++ai)
#pragma unroll
            for (int m = 0; m < 4; ++m) { const int row = row0 + ai * 128 + m * 16;
#pragma unroll
                for (int bj = 0; bj < 2; ++bj) { const pg8::f32x4 v0 = acc[ai][bj][m][0] * qs, v1 = acc[ai][bj][m][1] * qs;
                    pg8::u32x4 w; w.x = pg8::cvt_pk_bf16(v0[0], v0[1]); w.y = pg8::cvt_pk_bf16(v0[2], v0[3]); w.z = pg8::cvt_pk_bf16(v1[0], v1[1]); w.w = pg8::cvt_pk_bf16(v1[2], v1[3]);
                    if (u.pn == 2) { const int b = row >> 11, t = row & 2047, g = wc >> 1, d = 32 * (wc & 1) + 8 * fq;
                        *(pg8::u32x4*)(KCV + ((size_t)((bj * 16 + b) * 2 + g) * 2048 + t) * 64 + d) = w; }
                    else *(pg8::u32x4*)(O + (size_t)row * NCOL + u.pn * 256 + bj * 128 + wc * 32 + 8 * fq) = w; } }
    }
};
__device__ __forceinline__ void ph_win(const P& p, char* lds) {
    pg8::Gemm g{WS(bf16_t, W_HB), WS(bf16_t, W_WINB), 1024};
    StaticOrder S; S.init(T_, NCOL, (int)gridDim.x, (int)blockIdx.x);
    EpiCols E{WS(bf16_t, W_COLS), WS(bf16_t, W_KCVB)};
    pg8::RowsDense AM{2048u};
    pg8::gemm_phase<EpiCols, StaticOrder, pg8::RowsDense, true>((PG8_LAS unsigned char*)lds, g, S, E, AM);
}
struct EpiY { static constexpr bool PERM = true; static constexpr int NSTORE = 16;
    bf16_t* O;
    __device__ __forceinline__ void operator()(const pg8::f32x4 (&acc)[2][2][4][2], const pg8::Unit& u, int wr, int wc, int fr, int fq) const {
        const int row0 = u.pm * 256 + wr * 64 + fr, col0 = u.pn * 256 + wc * 32 + 8 * fq;
#pragma unroll
        for (int ai = 0; ai < 2; ++ai)
#pragma unroll
            for (int m = 0; m < 4; ++m) { bf16_t* rowp = O + (size_t)(row0 + ai * 128 + m * 16) * 1024 + col0;
#pragma unroll
                for (int bj = 0; bj < 2; ++bj) { const pg8::f32x4 v0 = acc[ai][bj][m][0] * WSCALE_INV, v1 = acc[ai][bj][m][1] * WSCALE_INV;
                    pg8::u32x4 w; w.x = pg8::cvt_pk_bf16(v0[0], v0[1]); w.y = pg8::cvt_pk_bf16(v0[2], v0[3]); w.z = pg8::cvt_pk_bf16(v1[0], v1[1]); w.w = pg8::cvt_pk_bf16(v1[2], v1[3]);
                    *(pg8::u32x4*)(rowp + bj * 128) = w; } }
    }
};
__device__ __forceinline__ void ph_wout(const P& p, char* lds) {
    pg8::Gemm g{(const bf16_t*)WS(unsigned char, W_MIXB), (const bf16_t*)WS(unsigned char, W_WOUTB), 512};
    StaticOrder S; S.init(T_, 1024, (int)gridDim.x, (int)blockIdx.x);
    EpiY E{WS(bf16_t, W_YB)};
    pg8::RowsDenseL AM{1024u};
    pg8::gemm_phase<EpiY, StaticOrder, pg8::RowsDenseL, true, 1>((PG8_LAS unsigned char*)lds, g, S, E, AM);
}

__device__ __forceinline__ void ph_prep(const P& p) {
    const int lane = threadIdx.x & 63;
    for (int tok = blockIdx.x * 8 + (threadIdx.x >> 6); tok < T_; tok += gridDim.x * 8) {
        const bf16_t* crow = WS(bf16_t, W_COLS) + (size_t)tok * NCOL;
        const float a0 = bf2f(crow[C_CKV + lane]), a1 = bf2f(crow[C_CKV + 64 + lane]);
        const float ss = wsum(a0 * a0 + a1 * a1);
        const float r = rsqrtf(ss * (1.f / 128.f) + 1e-6f);
        bf16_t* ck = WS(bf16_t, W_CKVN) + (size_t)tok * 128;
        ck[lane] = (bf16_t)f2bf(a0 * r * p.in[11][lane]); ck[64 + lane] = (bf16_t)f2bf(a1 * r * p.in[11][64 + lane]);
        const float kv = bf2f(crow[C_KI + lane]);
        const float mu = wsum(kv) * (1.f / 64.f);
        const float dv = kv - mu;
        const float var = wsum(dv * dv) * (1.f / 64.f);
        WS(bf16_t, W_KILN)[(size_t)tok * 64 + lane] = (bf16_t)f2bf(dv * rsqrtf(var + 1e-5f) * p.in[12][lane] + p.in[13][lane]);
    }
}

__device__ __forceinline__ unsigned ukey(float f) { const unsigned u = __float_as_uint(f); return (u & 0x80000000u) ? ~u : (u | 0x80000000u); }
__device__ __forceinline__ void ph_combine(const P& p) {
    const int lane = threadIdx.x & 63;
#pragma unroll 2
    for (int u = blockIdx.x * 8 + (threadIdx.x >> 6); u < T_; u += gridDim.x * 8) {
        unsigned char* mr = WS(unsigned char, W_MIXB) + (size_t)u * 1024;
#pragma unroll
        for (int half = 0; half < 2; ++half) { const bf16_t* src = (half ? WS(bf16_t, W_ODSA) : WS(bf16_t, W_ONSA)) + (size_t)u * 512; const float* gn = p.in[half ? 17 : 16];
            const uint2 ab = *(const uint2*)(src + lane * 4), cb = *(const uint2*)(src + 256 + lane * 4);
            const float4 a = make_float4(blo(ab.x), bhi(ab.x), blo(ab.y), bhi(ab.y)), c = make_float4(blo(cb.x), bhi(cb.x), blo(cb.y), bhi(cb.y));
            const float ss = wsum((a.x * a.x + a.y * a.y) + (a.z * a.z + a.w * a.w) + (c.x * c.x + c.y * c.y) + (c.z * c.z + c.w * c.w));
            const float r = rsqrtf(ss * (1.f / 512.f) + 1e-6f);
            const float4 g0 = *(const float4*)(gn + lane * 4), g1 = *(const float4*)(gn + 256 + lane * 4);
            *(unsigned*)(mr + half * 512 + lane * 4) = pk4_fp8(a.x * r * g0.x, a.y * r * g0.y, a.z * r * g0.z, a.w * r * g0.w);
            *(unsigned*)(mr + half * 512 + 256 + lane * 4) = pk4_fp8(c.x * r * g1.x, c.y * r * g1.y, c.z * r * g1.z, c.w * r * g1.w); }
    }
}
typedef short bf16x8_t __attribute__((ext_vector_type(8)));
typedef short s16x4_t __attribute__((ext_vector_type(4)));
typedef float f32x16_t __attribute__((ext_vector_type(16)));
typedef unsigned u32x4_t __attribute__((ext_vector_type(4)));
typedef float f32x2_t __attribute__((ext_vector_type(2))); typedef __bf16 bf16x2v_t __attribute__((ext_vector_type(2)));
__device__ __forceinline__ unsigned cvtpk_s(float lo, float hi) { const f32x2_t v = {lo, hi}; const bf16x2v_t b = __builtin_convertvector(v, bf16x2v_t); return __builtin_bit_cast(unsigned, b); }
constexpr float LOG2E = 1.4426950408889634f;
constexpr float C2S = 0.125f * LOG2E;
constexpr int AT_K = 0, AT_V = 16384, AT_TAB = 32768, AT_MISC = 40960;
__device__ __forceinline__ s16x4_t lds_tr16(LAS char* p) { return __builtin_bit_cast(s16x4_t, __builtin_amdgcn_ds_read_tr16_b64_v4i16((LAS s16x4_t*)p)); }
__device__ __forceinline__ void attn_fill_tab(const P& p, char* lds) {
    float* tab = (float*)(lds + AT_TAB);
    for (int i = threadIdx.x; i < 16 * 128; i += 512) tab[i] = p.in[18][bucket(i & 127) * 16 + (i >> 7)] * LOG2E;
    __syncthreads();
}
template <int MODE  >
__device__ __forceinline__ void ph_nsa_attn(const P& p, char* lds, bf16_t* onsa, int qslot) {
    int tid_ = threadIdx.x; asm volatile("" : "+v"(tid_));
    const int tid = tid_, lane = tid & 63, wid = __builtin_amdgcn_readfirstlane(tid >> 6), r32 = lane & 31, hi = lane >> 5, hr = wid & 3, th = wid >> 2;
    const unsigned lbase = (unsigned)(uintptr_t)lds;
    LAS char* L3 = (LAS char*)lds;
    const bf16_t* cols = WS(bf16_t, W_COLS);
    const LAS float* tab = (const LAS float*)(L3 + AT_TAB);
    unsigned* um_p = (unsigned*)(lds + AT_MISC);
    constexpr int CK = MODE == 0 ? C_KW : C_KS, CV = MODE == 0 ? C_VW : C_VS;
    const int skey = tid >> 3, sch = tid & 7;
    const unsigned kdst = AT_K + sch * 1024 + skey * 16, vdst = AT_V + ((sch >> 2) * 4 + (skey >> 4)) * 1024 + (skey & 15) * 64 + (sch & 3) * 16;
    const unsigned kfb = AT_K + hi * 1024 + r32 * 16;
    const unsigned vfb = AT_V + (4 * hi + ((lane & 15) >> 2)) * 64 + ((lane >> 4) & 1) * 32 + (lane & 3) * 8;
    attn_fill_tab(p, lds);
    for (int it = 0; it < 1024; ++it) {
        int vc;
        if (MODE == 0) { if (tid == 0) um_p[2] = atomicAdd(WS(unsigned, W_QCTR) + qslot, 1u); __syncthreads(); vc = (int)um_p[2]; __syncthreads(); }
        else vc = (int)blockIdx.x + it * (int)gridDim.x;
        if (vc >= 1024) break;
        const int cu = vc % 256, rep = vc / 256, bg = MODE == 1 ? 4 * (cu & 7) + (cu >> 6) : cu >> 3, s8 = MODE == 1 ? (cu >> 3) & 7 : cu & 7;
        const int qb = rep == 0 ? s8 : rep == 1 ? 15 - s8 : rep == 2 ? 16 + s8 : 31 - s8;
        const int b = bg >> 1, g = bg & 1, h = g * 4 + hr;
        const int tq = qb * 64 + th * 32 + r32; const size_t token = (size_t)b * 2048 + tq;
        const bf16_t* kvbase = cols + (size_t)b * 2048 * NCOL + g * 64;
        bf16x8_t qf[4];
        { const bf16_t* qp = cols + token * NCOL + C_QN + h * 64 + hi * 8;
#pragma unroll
          for (int d0 = 0; d0 < 4; ++d0) qf[d0] = *(const bf16x8_t*)(qp + 16 * d0); }
        const float gate = 1.f / (1.f + __expf(-bf2f(cols[token * NCOL + C_GATE + h * 3 + (MODE == 0 ? 2 : 1)])));
        unsigned mym = 0xffffffffu, um;
        if (MODE == 1) {
            mym = WS(unsigned, W_SELM)[token * 2 + g];
            unsigned w = mym;
#pragma unroll
            for (int o = 32; o > 0; o >>= 1) w |= (unsigned)__shfl_xor((int)w, o);
            if (tid == 0) *um_p = 0u;
            __syncthreads();
            if (lane == 0) atomicOr(um_p, w);
            __syncthreads();
            um = *um_p;
        } else { const int lo = qb - 8 < 0 ? 0 : qb - 8; um = (qb == 31 ? 0xffffffffu : ((1u << (qb + 1)) - 1u)) & ~((1u << lo) - 1u); }
        um = (unsigned)__builtin_amdgcn_readfirstlane((int)um);
        unsigned wm = mym;
        if (MODE == 1) {
#pragma unroll
            for (int o = 32; o > 0; o >>= 1) wm |= (unsigned)__shfl_xor((int)wm, o);
            wm = (unsigned)__builtin_amdgcn_readfirstlane((int)wm); }
        const LAS float* tabh = tab + h * 128; const float bfar = tabh[127];
        float m_run = -1e30f, l_run = 0.f; f32x16_t o0 = {}, o1 = {};
        int cur = __builtin_ctz(um); um &= um - 1u;
        u32x4_t kreg, vreg;
        { const bf16_t* src = kvbase + (size_t)(cur * 64 + skey) * NCOL + sch * 8; kreg = *(const u32x4_t*)(src + CK); vreg = *(const u32x4_t*)(src + CV); }
        *(LAS u32x4_t*)(L3 + kdst) = kreg; *(LAS u32x4_t*)(L3 + vdst) = vreg;
        __syncthreads();
        __builtin_amdgcn_s_waitcnt(0);
        int buf = 0;
        for (;;) {
            const int nxt = um ? __builtin_ctz(um) : -1; um &= um - 1u;
            if (nxt >= 0) { const bf16_t* src = kvbase + (size_t)(nxt * 64 + skey) * NCOL + sch * 8; kreg = *(const u32x4_t*)(src + CK); vreg = *(const u32x4_t*)(src + CV); }
            if (MODE == 0 || ((wm >> cur) & 1u)) {
                const unsigned kb_ = kfb + buf * 8192, vb_ = vfb + buf * 8192;
                const int kbase = cur * 64;
                const int dmin = (qb * 64 + th * 32) - (kbase + 63), dmax = (qb * 64 + th * 32 + 31) - kbase;
                const bool slow = (dmin < 128) || (MODE == 0 && dmax >= 512);
                const float c0 = slow ? 0.f : bfar;
                f32x16_t p0 = {c0, c0, c0, c0, c0, c0, c0, c0, c0, c0, c0, c0, c0, c0, c0, c0}, p1 = p0;
#pragma unroll
                for (int d0 = 0; d0 < 4; ++d0) {
                    const bf16x8_t k0 = *(const LAS bf16x8_t*)(L3 + kb_ + d0 * 2048);
                    const bf16x8_t k1 = *(const LAS bf16x8_t*)(L3 + kb_ + d0 * 2048 + 512);
                    p0 = __builtin_amdgcn_mfma_f32_32x32x16_bf16(k0, qf[d0], p0, 0, 0, 0);
                    p1 = __builtin_amdgcn_mfma_f32_32x32x16_bf16(k1, qf[d0], p1, 0, 0, 0); }
                if (slow) {
                    const int dq = tq - kbase - 4 * hi; const bool selq = (MODE == 0) || ((mym >> cur) & 1u);
                    float b0[16], b1[16];
#pragma unroll
                    for (int r = 0; r < 16; ++r) { const int c = (r & 3) + 8 * (r >> 2); const int d0_ = dq - c, d1_ = dq - c - 32;
                        b0[r] = tabh[d0_ < 0 ? 0 : (d0_ > 127 ? 127 : d0_)]; b1[r] = tabh[d1_ < 0 ? 0 : (d1_ > 127 ? 127 : d1_)]; }
                    asm volatile("" : "+v"(b0[0]), "+v"(b0[1]), "+v"(b0[2]), "+v"(b0[3]), "+v"(b0[4]), "+v"(b0[5]), "+v"(b0[6]), "+v"(b0[7]), "+v"(b0[8]), "+v"(b0[9]), "+v"(b0[10]), "+v"(b0[11]), "+v"(b0[12]), "+v"(b0[13]), "+v"(b0[14]), "+v"(b0[15]));
                    asm volatile("" : "+v"(b1[0]), "+v"(b1[1]), "+v"(b1[2]), "+v"(b1[3]), "+v"(b1[4]), "+v"(b1[5]), "+v"(b1[6]), "+v"(b1[7]), "+v"(b1[8]), "+v"(b1[9]), "+v"(b1[10]), "+v"(b1[11]), "+v"(b1[12]), "+v"(b1[13]), "+v"(b1[14]), "+v"(b1[15]));
#pragma unroll
                    for (int r = 0; r < 16; ++r) { const int c = (r & 3) + 8 * (r >> 2); const int d0_ = dq - c, d1_ = dq - c - 32;
                        const bool ok0 = selq && d0_ >= 0 && (MODE != 0 || d0_ < 512), ok1 = selq && d1_ >= 0 && (MODE != 0 || d1_ < 512);
                        p0[r] = ok0 ? p0[r] + b0[r] : -INFINITY; p1[r] = ok1 ? p1[r] + b1[r] : -INFINITY; }
                } else {
                    if (MODE == 1) { const bool selq = (mym >> cur) & 1u;
#pragma unroll
                        for (int r = 0; r < 16; ++r) { p0[r] = selq ? p0[r] : -INFINITY; p1[r] = selq ? p1[r] : -INFINITY; } }
                }
                float mx = fmaxf(p0[0], p1[0]);
#pragma unroll
                for (int r = 1; r < 16; ++r) mx = fmaxf(mx, fmaxf(p0[r], p1[r]));
                mx = fmaxf(mx, __shfl_xor(mx, 32));
                const float m_new = fmaxf(m_run, mx);
                const float alpha = __builtin_amdgcn_exp2f(m_run - m_new);
                m_run = m_new;
                float rs = 0.f;
#pragma unroll
                for (int r = 0; r < 16; ++r) { p0[r] = __builtin_amdgcn_exp2f(p0[r] - m_new); p1[r] = __builtin_amdgcn_exp2f(p1[r] - m_new); rs += p0[r] + p1[r]; }
                l_run = l_run * alpha + rs;
                if (__ballot(alpha != 1.f)) {
#pragma unroll
                    for (int r = 0; r < 16; ++r) { o0[r] *= alpha; o1[r] *= alpha; } }
#pragma unroll
                for (int ks = 0; ks < 4; ++ks) {
                    bf16x8_t pf;
                    { const f32x16_t& pp = (ks < 2) ? p0 : p1; const int s = (ks & 1) * 8;
                      const unsigned w0 = cvtpk_s(pp[s + 0], pp[s + 1]), w1 = cvtpk_s(pp[s + 2], pp[s + 3]), w2 = cvtpk_s(pp[s + 4], pp[s + 5]), w3 = cvtpk_s(pp[s + 6], pp[s + 7]);
                      const uint4 wv = make_uint4(w0, w1, w2, w3); pf = __builtin_bit_cast(bf16x8_t, wv); }
#pragma unroll
                    for (int db = 0; db < 2; ++db) {
                        const s16x4_t lo = lds_tr16(L3 + vb_ + (db * 4 + ks) * 1024), hh = lds_tr16(L3 + vb_ + (db * 4 + ks) * 1024 + 512);
                        const bf16x8_t vf = {lo[0], lo[1], lo[2], lo[3], hh[0], hh[1], hh[2], hh[3]};
                        if (db == 0) o0 = __builtin_amdgcn_mfma_f32_32x32x16_bf16(vf, pf, o0, 0, 0, 0); else o1 = __builtin_amdgcn_mfma_f32_32x32x16_bf16(vf, pf, o1, 0, 0, 0); }
                }
            }
            if (nxt >= 0) { *(LAS u32x4_t*)(L3 + kdst + (buf ^ 1) * 8192) = kreg; *(LAS u32x4_t*)(L3 + vdst + (buf ^ 1) * 8192) = vreg; }
            __syncthreads();
            if (nxt < 0) break;
            cur = nxt; buf ^= 1;
        }
        const float l_tot = l_run + __shfl_xor(l_run, 32);
        const float sc = l_tot > 0.f ? gate / l_tot : 0.f;
        bf16_t* op = onsa + token * 512 + h * 64 + 4 * hi;
#pragma unroll
        for (int db = 0; db < 2; ++db)
#pragma unroll
            for (int q4 = 0; q4 < 4; ++q4) { const f32x16_t& oo = db ? o1 : o0; uint2* dst = (uint2*)(op + 32 * db + 8 * q4);
                float4 v = make_float4(oo[4 * q4] * sc, oo[4 * q4 + 1] * sc, oo[4 * q4 + 2] * sc, oo[4 * q4 + 3] * sc);
                if (MODE == 1) { const uint2 old = *dst; v.x += blo(old.x); v.y += bhi(old.x); v.z += blo(old.y); v.w += bhi(old.y); }
                uint2 w; w.x = cvtpk_s(v.x, v.y); w.y = cvtpk_s(v.z, v.w); *dst = w; }
    }
}
constexpr int DA_K = 0, DA_V = 32768, DA_TAB = 65536;
__device__ __forceinline__ void ph_dsa_attn(const P& p, char* lds) {
    int tid_ = threadIdx.x; asm volatile("" : "+v"(tid_));
    const int tid = tid_, lane = tid & 63, h = __builtin_amdgcn_readfirstlane(tid >> 6), r32 = lane & 31, hi = lane >> 5;
    LAS char* L3 = (LAS char*)lds;
    const bf16_t* cols = WS(bf16_t, W_COLS); const bf16_t* ckvn = WS(bf16_t, W_CKVN);
    const bf16_t* wukb = WS(bf16_t, W_WUKB); const bf16_t* wuvt = WS(bf16_t, W_WUVT);
    { float* tab = (float*)(lds + DA_TAB);
      for (int i = tid; i < 16 * 128; i += 512) tab[i] = p.in[18][bucket(i & 127) * 16 + (i >> 7)] * LOG2E;
      __syncthreads(); }
    const LAS float* tabh = (const LAS float*)(L3 + DA_TAB) + (8 + h) * 128; const float bfar = tabh[127];
    unsigned kd0[2], vd[2]; int skey[2], sch[2];
#pragma unroll
    for (int i = 0; i < 2; ++i) { const int pc = tid + 512 * i; skey[i] = pc >> 4; sch[i] = pc & 15;
        kd0[i] = DA_K + (2 * sch[i]) * 512 + skey[i] * 8; vd[i] = DA_V + ((sch[i] >> 2) * 4 + (skey[i] >> 4)) * 1024 + (skey[i] & 15) * 64 + (sch[i] & 3) * 16; }
    const unsigned kfb = DA_K + hi * 512 + r32 * 8;
    const unsigned vfb = DA_V + (4 * hi + ((lane & 15) >> 2)) * 64 + ((lane >> 4) & 1) * 32 + (lane & 3) * 8;
    typedef unsigned u32x2_t __attribute__((ext_vector_type(2)));
    for (int it = 0; it < 4; ++it) {
        const int vc = (int)blockIdx.x + it * (int)gridDim.x; if (vc >= 1024) break;
        const int cu = vc % 256, rep = vc / 256, b = 2 * (cu & 7) + (cu >> 7), s16 = (cu >> 3) & 15;
        const int qb = rep == 0 ? s16 : rep == 1 ? 31 - s16 : rep == 2 ? 32 + s16 : 63 - s16;
        const int tq = qb * 32 + r32; const size_t token = (size_t)b * 2048 + tq;
        const bf16_t* kvbase = ckvn + (size_t)b * 2048 * 128;
        bf16x8_t qa[8];
        int wuko = (h * 128 + r32) * 64 + 8 * hi; asm volatile("" : "+v"(wuko)); const bf16_t* wukl = wukb + wuko;
        { bf16x8_t qd[4]; const bf16_t* qp = cols + token * NCOL + C_QD + h * 64 + hi * 8;
#pragma unroll
          for (int k0 = 0; k0 < 4; ++k0) qd[k0] = *(const bf16x8_t*)(qp + 16 * k0);
#pragma unroll
          for (int cb = 0; cb < 4; ++cb) { f32x16_t X = {}; __builtin_amdgcn_sched_barrier(0);
#pragma unroll
              for (int k0 = 0; k0 < 4; ++k0) { const bf16x8_t a = *(const bf16x8_t*)(wukl + cb * 2048 + 16 * k0); X = __builtin_amdgcn_mfma_f32_32x32x16_bf16(a, qd[k0], X, 0, 0, 0); }
#pragma unroll
              for (int s = 0; s < 2; ++s) { const u32x4_t wv = {cvtpk_s(X[8 * s + 0], X[8 * s + 1]), cvtpk_s(X[8 * s + 2], X[8 * s + 3]), cvtpk_s(X[8 * s + 4], X[8 * s + 5]), cvtpk_s(X[8 * s + 6], X[8 * s + 7])};
                  qa[2 * cb + s] = __builtin_bit_cast(bf16x8_t, wv); } } }
        const unsigned long long* mbase = WS(unsigned long long, W_DMASK) + ((size_t)b * 2048 + qb * 32) * 32; const int moff = r32 * 32;
        const int ntile = (qb >> 1) + 1;
        float m_run = -1e30f, l_run = 0.f; f32x16_t o[4] = {{}, {}, {}, {}};
        u32x4_t sreg[2];
#pragma unroll
        for (int i = 0; i < 2; ++i) sreg[i] = *(const u32x4_t*)(kvbase + (size_t)skey[i] * 128 + sch[i] * 8);
#pragma unroll
        for (int i = 0; i < 2; ++i) { *(LAS u32x2_t*)(L3 + kd0[i]) = (u32x2_t){sreg[i][0], sreg[i][1]}; *(LAS u32x2_t*)(L3 + kd0[i] + 512) = (u32x2_t){sreg[i][2], sreg[i][3]}; *(LAS u32x4_t*)(L3 + vd[i]) = sreg[i]; }
        unsigned long long mw = mbase[moff];
        __syncthreads();
        __builtin_amdgcn_s_waitcnt(0);
        int buf = 0;
        for (int cur = 0; cur < ntile; ++cur) {
            const bool more = cur + 1 < ntile;
            unsigned long long mwn = 0ull;
            if (more) {
#pragma unroll
                for (int i = 0; i < 2; ++i) sreg[i] = *(const u32x4_t*)(kvbase + (size_t)((cur + 1) * 64 + skey[i]) * 128 + sch[i] * 8);
                mwn = mbase[moff + cur + 1]; }
            {
                const unsigned kb_ = kfb + buf * 16384, vb_ = vfb + buf * 16384;
                const int kbase = cur * 64;
                const bool slow = (qb * 32 - (kbase + 63)) < 128;
                const float c0 = slow ? 0.f : bfar;
                f32x16_t p0 = {c0, c0, c0, c0, c0, c0, c0, c0, c0, c0, c0, c0, c0, c0, c0, c0}, p1 = p0;
#pragma unroll
                for (int kc = 0; kc < 8; ++kc) {
                    __builtin_amdgcn_sched_barrier(0);
                    const u32x2_t a0 = *(const LAS u32x2_t*)(L3 + kb_ + kc * 2048), a1 = *(const LAS u32x2_t*)(L3 + kb_ + kc * 2048 + 1024);
                    const u32x2_t b0 = *(const LAS u32x2_t*)(L3 + kb_ + kc * 2048 + 256), b1 = *(const LAS u32x2_t*)(L3 + kb_ + kc * 2048 + 256 + 1024);
                    const u32x4_t ka = {a0[0], a0[1], a1[0], a1[1]}, kb2 = {b0[0], b0[1], b1[0], b1[1]};
                    p0 = __builtin_amdgcn_mfma_f32_32x32x16_bf16(__builtin_bit_cast(bf16x8_t, ka), qa[kc], p0, 0, 0, 0);
                    p1 = __builtin_amdgcn_mfma_f32_32x32x16_bf16(__builtin_bit_cast(bf16x8_t, kb2), qa[kc], p1, 0, 0, 0); }
                __builtin_amdgcn_sched_barrier(0);
                unsigned mlo = (unsigned)mw >> (4 * hi), mhi = (unsigned)(mw >> 32) >> (4 * hi);
                if (slow) { const int dq = tq - kbase - 4 * hi; asm volatile("" : "+v"(mlo), "+v"(mhi));
                    float b0[16], b1[16];
#pragma unroll
                    for (int r = 0; r < 16; ++r) { const int c = (r & 3) + 8 * (r >> 2); const int d0_ = dq - c, d1_ = dq - c - 32;
                        b0[r] = tabh[d0_ < 0 ? 0 : (d0_ > 127 ? 127 : d0_)]; b1[r] = tabh[d1_ < 0 ? 0 : (d1_ > 127 ? 127 : d1_)]; }
                    asm volatile("" : "+v"(b0[0]), "+v"(b0[1]), "+v"(b0[2]), "+v"(b0[3]), "+v"(b0[4]), "+v"(b0[5]), "+v"(b0[6]), "+v"(b0[7]), "+v"(b0[8]), "+v"(b0[9]), "+v"(b0[10]), "+v"(b0[11]), "+v"(b0[12]), "+v"(b0[13]), "+v"(b0[14]), "+v"(b0[15]));
                    asm volatile("" : "+v"(b1[0]), "+v"(b1[1]), "+v"(b1[2]), "+v"(b1[3]), "+v"(b1[4]), "+v"(b1[5]), "+v"(b1[6]), "+v"(b1[7]), "+v"(b1[8]), "+v"(b1[9]), "+v"(b1[10]), "+v"(b1[11]), "+v"(b1[12]), "+v"(b1[13]), "+v"(b1[14]), "+v"(b1[15]));
#pragma unroll
                    for (int r = 0; r < 16; ++r) { const int c = (r & 3) + 8 * (r >> 2);
                        p0[r] = ((mlo >> c) & 1u) ? p0[r] + b0[r] : -INFINITY; p1[r] = ((mhi >> c) & 1u) ? p1[r] + b1[r] : -INFINITY; }
                } else { asm volatile("" : "+v"(mlo), "+v"(mhi));
#pragma unroll
                    for (int r = 0; r < 16; ++r) { const int c = (r & 3) + 8 * (r >> 2);
                        p0[r] = ((mlo >> c) & 1u) ? p0[r] : -INFINITY; p1[r] = ((mhi >> c) & 1u) ? p1[r] : -INFINITY; } }
                float mx = fmaxf(p0[0], p1[0]);
#pragma unroll
                for (int r = 1; r < 16; ++r) mx = fmaxf(mx, fmaxf(p0[r], p1[r]));
                mx = fmaxf(mx, __shfl_xor(mx, 32));
                const float m_new = fmaxf(m_run, mx);
                const float alpha = __builtin_amdgcn_exp2f(m_run - m_new);
                m_run = m_new;
                float rs = 0.f;
#pragma unroll
                for (int r = 0; r < 16; ++r) { p0[r] = __builtin_amdgcn_exp2f(p0[r] - m_new); p1[r] = __builtin_amdgcn_exp2f(p1[r] - m_new); rs += p0[r] + p1[r]; }
                l_run = l_run * alpha + rs;
                if (__ballot(alpha != 1.f)) {
#pragma unroll
                    for (int cb = 0; cb < 4; ++cb)
#pragma unroll
                        for (int r = 0; r < 16; ++r) o[cb][r] *= alpha; }
#pragma unroll
                for (int ks = 0; ks < 4; ++ks) {
                    __builtin_amdgcn_sched_barrier(0);
                    bf16x8_t pf;
                    { const f32x16_t& pp = (ks < 2) ? p0 : p1; const int s = (ks & 1) * 8;
                      const u32x4_t wv = {cvtpk_s(pp[s + 0], pp[s + 1]), cvtpk_s(pp[s + 2], pp[s + 3]), cvtpk_s(pp[s + 4], pp[s + 5]), cvtpk_s(pp[s + 6], pp[s + 7])};
                      pf = __builtin_bit_cast(bf16x8_t, wv); }
#pragma unroll
                    for (int cb = 0; cb < 4; ++cb) {
                        const s16x4_t lo = lds_tr16(L3 + vb_ + (cb * 4 + ks) * 1024), hh = lds_tr16(L3 + vb_ + (cb * 4 + ks) * 1024 + 512);
                        const bf16x8_t vf = {lo[0], lo[1], lo[2], lo[3], hh[0], hh[1], hh[2], hh[3]};
                        o[cb] = __builtin_amdgcn_mfma_f32_32x32x16_bf16(vf, pf, o[cb], 0, 0, 0); }
                }
            }
            if (more) {
#pragma unroll
                for (int i = 0; i < 2; ++i) { const unsigned ob = (buf ^ 1) * 16384; *(LAS u32x2_t*)(L3 + kd0[i] + ob) = (u32x2_t){sreg[i][0], sreg[i][1]}; *(LAS u32x2_t*)(L3 + kd0[i] + ob + 512) = (u32x2_t){sreg[i][2], sreg[i][3]}; *(LAS u32x4_t*)(L3 + vd[i] + ob) = sreg[i]; } }
            __syncthreads();
            mw = mwn; buf ^= 1;
        }
        const float l_tot = l_run + __shfl_xor(l_run, 32);
        const float inv = l_tot > 0.f ? 1.f / l_tot : 0.f;
        f32x16_t od[2] = {{}, {}};
        int wuvo = (h * 64 + r32) * 128 + 4 * hi; asm volatile("" : "+v"(wuvo)); const bf16_t* wuvl = wuvt + wuvo;
#pragma unroll
        for (int cb = 0; cb < 4; ++cb)
#pragma unroll
            for (int s = 0; s < 2; ++s) {
                __builtin_amdgcn_sched_barrier(0);
                const u32x4_t wv = {cvtpk_s(o[cb][8 * s + 0] * inv, o[cb][8 * s + 1] * inv), cvtpk_s(o[cb][8 * s + 2] * inv, o[cb][8 * s + 3] * inv),
                                    cvtpk_s(o[cb][8 * s + 4] * inv, o[cb][8 * s + 5] * inv), cvtpk_s(o[cb][8 * s + 6] * inv, o[cb][8 * s + 7] * inv)};
                const bf16x8_t of = __builtin_bit_cast(bf16x8_t, wv);
#pragma unroll
                for (int db = 0; db < 2; ++db) { const bf16_t* wp = wuvl + db * 4096 + 32 * cb + 16 * s;
                    const u32x2_t w0 = *(const u32x2_t*)wp, w1 = *(const u32x2_t*)(wp + 8); const u32x4_t wf = {w0[0], w0[1], w1[0], w1[1]};
                    od[db] = __builtin_amdgcn_mfma_f32_32x32x16_bf16(__builtin_bit_cast(bf16x8_t, wf), of, od[db], 0, 0, 0); } }
        bf16_t* op = WS(bf16_t, W_ODSA) + ((size_t)b * 2048 + qb * 32) * 512 + r32 * 512 + h * 64 + 4 * hi;
#pragma unroll
        for (int db = 0; db < 2; ++db)
#pragma unroll
            for (int q4 = 0; q4 < 4; ++q4) { uint2 w; w.x = cvtpk_s(od[db][4 * q4], od[db][4 * q4 + 1]); w.y = cvtpk_s(od[db][4 * q4 + 2], od[db][4 * q4 + 3]); *(uint2*)(op + 32 * db + 8 * q4) = w; }
    }
}
__device__ __forceinline__ int wsum_dpp(int v) {
    v += __builtin_amdgcn_update_dpp(0, v, 0xB1, 0xF, 0xF, false);
    v += __builtin_amdgcn_update_dpp(0, v, 0x4E, 0xF, 0xF, false);
    v += __builtin_amdgcn_update_dpp(0, v, 0x141, 0xF, 0xF, false);
    v += __builtin_amdgcn_update_dpp(0, v, 0x140, 0xF, 0xF, false);
    return __builtin_amdgcn_readlane(v, 0) + __builtin_amdgcn_readlane(v, 16) + __builtin_amdgcn_readlane(v, 32) + __builtin_amdgcn_readlane(v, 48);
}
constexpr int DI_SC = 0, DI_K = 131072;
template <int PARTS>
__device__ __forceinline__ void ph_dsa_index(const P& p, char* lds, unsigned long long* dmask) {
    int tid_ = threadIdx.x; asm volatile("" : "+v"(tid_));
    const int tid = tid_, lane = tid & 63, wid = __builtin_amdgcn_readfirstlane(tid >> 6), r32 = lane & 31, hi = lane >> 5, rb2 = wid & 1, par = wid >> 1;
    LAS char* L3 = (LAS char*)lds;
    float* sc = (float*)(lds + DI_SC);
    const bf16_t* cols = WS(bf16_t, W_COLS); const bf16_t* kiln = WS(bf16_t, W_KILN);
    for (int it = 0; it < 8; ++it) {
        const int vc = (int)blockIdx.x + it * (int)gridDim.x; if (vc >= 2048) break;
        const int cu = vc % 256, rep = vc / 256, b = 2 * (cu & 7) + (cu >> 7), s16 = (cu >> 3) & 15;
        const int tb = (rep >> 1) * 32 + ((rep & 1) ? 31 - s16 : s16);
        const int t0 = tb * 16;
        const bf16_t* kbase_p = kiln + (size_t)b * 2048 * 64;
        bf16x8_t qf[2][4]; float wgt[2][16];
#pragma unroll
        for (int rb = 0; rb < 2; ++rb) { const int rowblk = 2 * rb2 + rb;
          const size_t tok = (size_t)b * 2048 + t0 + 4 * rowblk + (r32 >> 3); const bf16_t* qp = cols + tok * NCOL + C_QI + (r32 & 7) * 64 + hi * 8;
#pragma unroll
          for (int d0 = 0; d0 < 4; ++d0) qf[rb][d0] = *(const bf16x8_t*)(qp + 16 * d0);
#pragma unroll
          for (int r = 0; r < 16; ++r) wgt[rb][r] = bf2f(cols[((size_t)b * 2048 + t0 + 4 * rowblk + (r >> 2)) * NCOL + C_WI + (r & 3) + 4 * hi]) * 0.044194173824159216f; }
        const int ntile = ((t0 + 15) >> 6) + 1;
        int klo = r32 * 64 + 8 * hi; asm volatile("" : "+v"(klo));
        const bf16_t* kl = kbase_p + klo;
        bf16x8_t kf[8], kn[8];
        if ((PARTS & 1) && par < ntile) {
#pragma unroll
            for (int q = 0; q < 8; ++q) kf[q] = *(const bf16x8_t*)(kl + (size_t)(par * 64 + 32 * (q >> 2)) * 64 + 16 * (q & 3)); }
        __builtin_amdgcn_s_waitcnt(0);
#pragma unroll 1
        for (int kt = par; (PARTS & 1) && kt < ntile; kt += 4) {
            const bool more = kt + 4 < ntile;
            if (more) {
#pragma unroll
                for (int q = 0; q < 8; ++q) kn[q] = *(const bf16x8_t*)(kl + (size_t)((kt + 4) * 64 + 32 * (q >> 2)) * 64 + 16 * (q & 3)); }
#pragma unroll
            for (int rb = 0; rb < 2; ++rb)
#pragma unroll
            for (int cbk = 0; cbk < 2; ++cbk) {
                f32x16_t C = {};
#pragma unroll
                for (int d0 = 0; d0 < 4; ++d0) C = __builtin_amdgcn_mfma_f32_32x32x16_bf16(qf[rb][d0], kf[4 * cbk + d0], C, 0, 0, 0);
                float part[4];
#pragma unroll
                for (int tl = 0; tl < 4; ++tl) { float a = 0.f;
#pragma unroll
                    for (int hh = 0; hh < 4; ++hh) a += fmaxf(C[4 * tl + hh], 0.f) * wgt[rb][4 * tl + hh];
                    const auto rr = __builtin_amdgcn_permlane32_swap(__float_as_uint(a), __float_as_uint(a), false, false); part[tl] = __uint_as_float(rr[0]) + __uint_as_float(rr[1]); }
                float* dst = sc + (4 * (2 * rb2 + rb)) * 2048 + kt * 64 + 32 * cbk + r32;
                if (hi == 0) { dst[0] = part[0]; dst[2048] = part[1]; } else { dst[2 * 2048] = part[2]; dst[3 * 2048] = part[3]; }
            }
            if (more) {
#pragma unroll
                for (int q = 0; q < 8; ++q) kf[q] = kn[q]; }
        }
        __syncthreads();
#pragma unroll 1
        for (int tt = 0; (PARTS & 2) && tt < 2; ++tt) {
            const int tl = 2 * wid + tt, t = t0 + tl, n = t + 1, ni = (n + 63) >> 6;
            const float* srow = sc + tl * 2048;
            unsigned long long myword = 0ull;
            if (n <= 256) {
#pragma unroll
                for (int i = 0; i < 4; ++i) { const unsigned long long w = __ballot(64 * i + lane < n); if (lane == i) myword = w; }
            } else {
                float f[32];
#pragma unroll
                for (int i = 0; i < 32; ++i) { const int s = 64 * i + lane; const float v = srow[s]; f[i] = (s < n) ? v : __builtin_nanf(""); }
                float fmn = INFINITY, fmx = -INFINITY;
#pragma unroll
                for (int g = 0; g < 4; ++g) if (ni > 8 * g) {
#pragma unroll
                    for (int i = 0; i < 8; ++i) { fmn = fminf(fmn, f[8 * g + i]); fmx = fmaxf(fmx, f[8 * g + i]); } }
#pragma unroll
                for (int o = 32; o > 0; o >>= 1) { fmn = fminf(fmn, __shfl_xor(fmn, o)); fmx = fmaxf(fmx, __shfl_xor(fmx, o)); }
                unsigned* hist = (unsigned*)srow;
                bool done = false;
                if (fmx > fmn) {
                    const float scale = 2047.5f / (fmx - fmn), off = -fmn * scale;
                    asm volatile("s_waitcnt lgkmcnt(0)" ::: "memory");
#pragma unroll
                    for (int q = 0; q < 8; ++q) ((uint4*)hist)[lane + 64 * q] = make_uint4(0u, 0u, 0u, 0u);
                    asm volatile("s_waitcnt lgkmcnt(0)" ::: "memory");
#pragma unroll
                    for (int g = 0; g < 4; ++g) if (ni > 8 * g) {
#pragma unroll
                        for (int i = 0; i < 8; ++i) { const int bq = (int)fmaxf(fmaf(f[8 * g + i], scale, off), 0.f); atomicAdd(hist + bq, 1u); } }
                    asm volatile("s_waitcnt lgkmcnt(0)" ::: "memory");
                    const int ndump = 512 * ((ni + 7) >> 3) - n;
                    int sl = 0; { int ln = lane; asm volatile("" : "+v"(ln));
#pragma unroll
                    for (int q = 0; q < 32; ++q) sl += (int)hist[32 * ln + ((q + ln) & 31)]; }
                    if (lane == 0) sl -= ndump;
                    int incl = sl;
#pragma unroll
                    for (int d = 1; d < 64; d <<= 1) { const int tv = __shfl_down(incl, d); if (lane + d < 64) incl += tv; }
                    const int excl = incl - sl;
                    const unsigned long long crs = __ballot(excl < 256 && incl >= 256);
                    const int Ls = __builtin_ctzll(crs); const int chi = __builtin_amdgcn_readlane(excl, Ls);
                    int c2 = (lane < 32) ? (int)hist[32 * Ls + lane] : 0; if (Ls == 0 && lane == 0) c2 -= ndump;
                    int incl2 = c2;
#pragma unroll
                    for (int d = 1; d < 32; d <<= 1) { const int tv = __shfl_down(incl2, d); if (lane + d < 32) incl2 += tv; }
                    const int excl2 = incl2 - c2;
                    const unsigned long long crs2 = __ballot(lane < 32 && chi + excl2 < 256 && chi + incl2 >= 256);
                    const int js = __builtin_ctzll(crs2); const int bstar = 32 * Ls + js;
                    const int cab = chi + __builtin_amdgcn_readlane(excl2, js), m = __builtin_amdgcn_readlane(c2, js), need = 256 - cab;
                    if (crs != 0ull && crs2 != 0ull && m <= 64 && need >= 1 && need <= m) {
                        unsigned* cl = (unsigned*)(lds + 147456 + wid * 256);
                        int base = 0;
#pragma unroll
                        for (int g = 0; g < 4; ++g) if (ni > 8 * g) {
#pragma unroll
                            for (int i = 0; i < 8; ++i) { const int bq = (int)fmaxf(fmaf(f[8 * g + i], scale, off), 0.f); const bool inb = (bq == bstar) && (64 * (8 * g + i) + lane < n); const unsigned long long bal = __ballot(inb);
                                if (bal) { const int slot = base + __builtin_amdgcn_mbcnt_hi((unsigned)(bal >> 32), __builtin_amdgcn_mbcnt_lo((unsigned)bal, 0u)); if (inb) cl[slot & 63] = ukey(f[8 * g + i]); base += __builtin_popcountll(bal); } } }
                        asm volatile("s_waitcnt lgkmcnt(0)" ::: "memory");
                        const bool vld = lane < m; const unsigned mine = vld ? cl[lane] : 0u;
                        unsigned T = 0u;
#pragma unroll 1
                        for (int bit = 31; bit >= 0; --bit) { const unsigned c = T | (1u << bit); if (__builtin_popcountll(__ballot(vld && mine >= c)) >= need) T = c; }
                        int rem = need - __builtin_popcountll(__ballot(vld && mine > T));
                        asm volatile("s_waitcnt lgkmcnt(0)" ::: "memory");
                        if (base == m) {
#pragma unroll
                            for (int g = 0; g < 4; ++g) if (ni > 8 * g) {
#pragma unroll
                                for (int i = 0; i < 8; ++i) { const int bq = (int)fmaxf(fmaf(f[8 * g + i], scale, off), 0.f); unsigned long long w = __ballot(bq > bstar);
                                    const bool inb = (bq == bstar) && (64 * (8 * g + i) + lane < n); const unsigned long long inq = __ballot(inb);
                                    if (inq) { const unsigned kv = ukey(f[8 * g + i]); w |= __ballot(inb && kv > T); const unsigned long long eqb = __ballot(inb && kv == T);
                                        if (eqb) { const int rk = __builtin_amdgcn_mbcnt_hi((unsigned)(eqb >> 32), __builtin_amdgcn_mbcnt_lo((unsigned)eqb, 0u)); w |= __ballot(inb && kv == T && rk < rem); rem -= __builtin_popcountll(eqb); rem = rem < 0 ? 0 : rem; } }
                                    if (lane == 8 * g + i) myword = w; } }
                            done = true;
                        }
                    }
                }
                if (!done) {
                    unsigned k[32];
    #pragma unroll
                    for (int i = 0; i < 32; ++i) { const int s = 64 * i + lane; k[i] = (s < n) ? ukey(f[i]) : 0u; }
    #define DI_COUNT(dst, EXPR) do { int c_ = 0; \
                        _Pragma("unroll") for (int g_ = 0; g_ < 4; ++g_) if (ni > 8 * g_) { _Pragma("unroll") for (int i_ = 0; i_ < 8; ++i_) { const unsigned kv_ = k[8 * g_ + i_]; c_ += (EXPR) ? 1 : 0; } } \
                        dst = wsum_dpp(c_); } while (0)
                    unsigned prefix = 0u; int cge = 0;
    #pragma unroll 1
                    for (int bit = 31; bit >= 16; --bit) { const unsigned cand = prefix | (1u << bit); int tot; DI_COUNT(tot, kv_ >= cand); if (tot >= 256) { prefix = cand; cge = tot; } }
                    int cab = 0;
                    if (prefix < 0xffff0000u) { const unsigned hb = prefix + 0x10000u; DI_COUNT(cab, kv_ >= hb); }
                    const int m = cge - cab, need = 256 - cab;
                    unsigned T; int cgt;
                    if (m <= 64) {
                        unsigned* cl = (unsigned*)(lds + 147456 + wid * 256);
                        int base = 0;
    #pragma unroll
                        for (int g = 0; g < 4; ++g) if (ni > 8 * g) {
    #pragma unroll
                            for (int i = 0; i < 8; ++i) { const unsigned kv = k[8 * g + i]; const bool inb = (kv - prefix) < 0x10000u; const unsigned long long bal = __ballot(inb);
                                if (bal) { const int slot = base + __builtin_amdgcn_mbcnt_hi((unsigned)(bal >> 32), __builtin_amdgcn_mbcnt_lo((unsigned)bal, 0u)); if (inb) cl[slot] = kv & 0xffffu; base += __builtin_popcountll(bal); } } }
                        __builtin_amdgcn_fence(__ATOMIC_RELEASE, "wavefront"); asm volatile("s_waitcnt lgkmcnt(0)" ::: "memory");
                        const bool vld = lane < m; const unsigned mine = vld ? cl[lane] : 0u;
                        unsigned pl = 0u;
    #pragma unroll 1
                        for (int bit = 15; bit >= 0; --bit) { const unsigned c = pl | (1u << bit); if (__builtin_popcountll(__ballot(vld && mine >= c)) >= need) pl = c; }
                        T = prefix | pl; cgt = cab + __builtin_popcountll(__ballot(vld && mine > pl));
                        asm volatile("s_waitcnt lgkmcnt(0)" ::: "memory");
                    } else {
    #pragma unroll 1
                        for (int bit = 15; bit >= 0; --bit) { const unsigned cand = prefix | (1u << bit); int tot; DI_COUNT(tot, kv_ >= cand); if (tot >= 256) prefix = cand; }
                        T = prefix; DI_COUNT(cgt, kv_ > T);
                    }
                    int rem = 256 - cgt;
    #pragma unroll
                    for (int g = 0; g < 4; ++g) if (ni > 8 * g) {
    #pragma unroll
                        for (int i = 0; i < 8; ++i) { const unsigned kv = k[8 * g + i]; unsigned long long w = __ballot(kv > T); const unsigned long long eqb = __ballot(kv == T);
                            if (eqb) { const int rk = __builtin_amdgcn_mbcnt_hi((unsigned)(eqb >> 32), __builtin_amdgcn_mbcnt_lo((unsigned)eqb, 0u)); w |= __ballot(kv == T && rk < rem); rem -= __builtin_popcountll(eqb); rem = rem < 0 ? 0 : rem; }
                            if (lane == 8 * g + i) myword = w; } }
#undef DI_COUNT
                }
            }
            if (lane < 32) dmask[((size_t)b * 2048 + t) * 32 + lane] = myword;
        }
        __syncthreads();
    }
}
constexpr int LR_HS = 0, LR_ROW = 1028, LR_LGT = 135168;
typedef float f32x16r_t __attribute__((ext_vector_type(16)));
template <int PARTS>
__device__ __forceinline__ void ph_lnroute_fast(const P& p, char* lds, bf16_t* xout, unsigned char* h2out, int* cntb, int* tope, float* topw, int* pos, int* bbase) {
    int tid_ = threadIdx.x; asm volatile("" : "+v"(tid_));
    const int tid = tid_, lane = tid & 63, wid = tid >> 6, r32 = lane & 31, hi = lane >> 5;
    float* hs = (float*)(lds + LR_HS); float* lgt = (float*)(lds + LR_LGT);
    const float* ada = WS(float, W_ADA);
    int* lcnt = (int*)(lds + LR_LGT + 4096);
    if (tid < NCHUNK * 32) lcnt[tid] = 0;
    __syncthreads();
    for (int blk = blockIdx.x; blk < T_ / 32; blk += gridDim.x) {
        float4 z[4][4];
#pragma unroll
        for (int tt = 0; tt < 4; ++tt) { const size_t u_ = (size_t)(blk * 32 + 4 * wid + tt); const float* xrow = p.in[0] + u_ * 1024; const bf16_t* yrow = WS(bf16_t, W_YB) + u_ * 1024; const float* g1 = ada + (int)(u_ >> 11) * 6144 + 2048;
#pragma unroll
            for (int j = 0; j < 4; ++j) { const int c = j * 256 + lane * 4; const float4 xv = *(const float4*)(xrow + c), gv = *(const float4*)(g1 + c); const uint2 yv = *(const uint2*)(yrow + c);
                z[tt][j] = make_float4(ALPHA * xv.x + (1.f + gv.x) * blo(yv.x), ALPHA * xv.y + (1.f + gv.y) * bhi(yv.x), ALPHA * xv.z + (1.f + gv.z) * blo(yv.y), ALPHA * xv.w + (1.f + gv.w) * bhi(yv.y)); } }
#pragma unroll
        for (int tt = 0; tt < 4; ++tt) {
            const int tl = 4 * wid + tt, u = blk * 32 + tl, b = u >> 11;
            float s = 0.f;
#pragma unroll
            for (int j = 0; j < 4; ++j) s += (z[tt][j].x + z[tt][j].y) + (z[tt][j].z + z[tt][j].w);
            const float mu = wsum(s) * (1.f / 1024.f); float q = 0.f;
#pragma unroll
            for (int j = 0; j < 4; ++j) { z[tt][j].x -= mu; z[tt][j].y -= mu; z[tt][j].z -= mu; z[tt][j].w -= mu; q += (z[tt][j].x * z[tt][j].x + z[tt][j].y * z[tt][j].y) + (z[tt][j].z * z[tt][j].z + z[tt][j].w * z[tt][j].w); }
            const float rs = rsqrtf(wsum(q) * (1.f / 1024.f) + 1e-5f);
#pragma unroll
            for (int j = 0; j < 4; ++j) { const int c = j * 256 + lane * 4;
                const float4 gn = *(const float4*)(p.in[20] + c), bs = *(const float4*)(p.in[21] + c);
                const float4 x1 = make_float4(z[tt][j].x * rs * gn.x + bs.x, z[tt][j].y * rs * gn.y + bs.y, z[tt][j].z * rs * gn.z + bs.z, z[tt][j].w * rs * gn.w + bs.w);
                { uint2 xo; xo.x = pk2(x1.x, x1.y); xo.y = pk2(x1.z, x1.w); *(uint2*)(xout + (size_t)u * 1024 + c) = xo; }
                const float4 sc = *(const float4*)(ada + b * 6144 + 4096 + c), sh = *(const float4*)(ada + b * 6144 + 3072 + c);
                const float4 h = make_float4(x1.x * (1.f + sc.x) + sh.x, x1.y * (1.f + sc.y) + sh.y, x1.z * (1.f + sc.z) + sh.z, x1.w * (1.f + sc.w) + sh.w);
                *(unsigned*)(h2out + (size_t)u * 1024 + c) = pk4_fp8(h.x, h.y, h.z, h.w);
                *(float4*)(hs + tl * LR_ROW + c) = h; }
        }
        __syncthreads();
        if (!(PARTS & 2)) continue;
        f32x16r_t C = {};
        { const float* ap = hs + r32 * LR_ROW + 128 * wid; const float* wp = p.in[22] + (size_t)(128 * wid + hi) * 32 + r32;
#pragma unroll 4
          for (int k4 = 0; k4 < 32; ++k4) { const float4 av = *(const float4*)(ap + 4 * k4);
              const float b0 = wp[(4 * k4) * 32], b1 = wp[(4 * k4 + 2) * 32];
              C = __builtin_amdgcn_mfma_f32_32x32x2f32(hi ? av.y : av.x, b0, C, 0, 0, 0);
              C = __builtin_amdgcn_mfma_f32_32x32x2f32(hi ? av.w : av.z, b1, C, 0, 0, 0); } }
        __syncthreads();
        { float* part = hs + wid * 1024;
#pragma unroll
          for (int r = 0; r < 16; ++r) part[((r & 3) + 8 * (r >> 2) + 4 * hi) * 32 + r32] = C[r]; }
        __syncthreads();
#pragma unroll
        for (int i2 = 0; i2 < 2; ++i2) { const int o = tid + 512 * i2; float a = p.in[23][o & 31];
#pragma unroll
            for (int w = 0; w < 8; ++w) a += hs[w * 1024 + o];
            lgt[o] = a; }
        __syncthreads();
        if ((PARTS & 4) && tid < 32) { const int u = blk * 32 + tid; float lv[32];
#pragma unroll
            for (int q = 0; q < 8; ++q) { const float4 v = *(const float4*)(lgt + tid * 32 + 4 * q); lv[4 * q] = v.x; lv[4 * q + 1] = v.y; lv[4 * q + 2] = v.z; lv[4 * q + 3] = v.w; }
            int te[4]; float tv[4]; unsigned used = 0u;
#pragma unroll
            for (int k = 0; k < 4; ++k) { int best = 0; float bv = -INFINITY;
#pragma unroll
                for (int e = 0; e < 32; ++e) { const bool take = !((used >> e) & 1u) && (lv[e] > bv); best = take ? e : best; bv = take ? lv[e] : bv; }
                used |= 1u << best; te[k] = best; tv[k] = bv; }
            const float m = tv[0]; float ex[4], sm = 0.f;
#pragma unroll
            for (int k = 0; k < 4; ++k) { ex[k] = expf(tv[k] - m); sm += ex[k]; }
            const int ch = u / CHT;
#pragma unroll
            for (int k = 0; k < 4; ++k) { tope[u * 4 + k] = te[k]; topw[u * 4 + k] = ex[k] / sm;
                pos[u * 4 + k] = atomicAdd(lcnt + ch * 32 + te[k], 1); } }
        __syncthreads();
    }
    if ((PARTS & 4) && tid < NCHUNK * 32) { const int c = lcnt[tid]; bbase[blockIdx.x * (NCHUNK * 32) + tid] = c ? atomicAdd(cntb + tid, c) : 0; }
}
constexpr int CA_K = 0, CA_V = 16384, CA_TAB = 32768, CA_PS = 40960, CA_IMP = 73728;
__device__ __forceinline__ void ph_nsa_cmp(const P& p, char* lds, bf16_t* onsa) {
    int tid_ = threadIdx.x; asm volatile("" : "+v"(tid_));
    const int tid = tid_, lane = tid & 63, wid = __builtin_amdgcn_readfirstlane(tid >> 6), r32 = lane & 31, hi = lane >> 5, hr = r32 & 3;
    LAS char* L3 = (LAS char*)lds;
    const bf16_t* cols = WS(bf16_t, W_COLS);
    float* Ps = (float*)(lds + CA_PS); float* impS = (float*)(lds + CA_IMP);
    { float* tab = (float*)(lds + CA_TAB);
      for (int i = tid; i < 16 * 128; i += 512) tab[i] = p.in[18][bucket(i & 127) * 16 + (i >> 7)] * LOG2E;
      __syncthreads(); }
    const unsigned kfb = CA_K + hi * 2048 + r32 * 16;
    const unsigned vfb = CA_V + (4 * hi + ((lane & 15) >> 2)) * 64 + ((lane >> 4) & 1) * 32 + (lane & 3) * 8;
    for (int vc = blockIdx.x; vc < 1024; vc += gridDim.x) {
        const int bg = vc >> 5, qb = ((vc & 31) + 16 * (vc >> 8)) & 31, b = bg >> 1, g = bg & 1, h = g * 4 + hr;
        const int tloc = 8 * wid + (r32 >> 2), tq = qb * 64 + tloc; const size_t token = (size_t)b * 2048 + tq;
        { const int key = tid >> 2, qtr = tid & 3;
          const float* ksrc = WS(float, W_KC) + ((size_t)(b * NC + key) * 2 + g) * 64 + qtr * 16; const float* vsrc = WS(float, W_VC) + ((size_t)(b * NC + key) * 2 + g) * 64 + qtr * 16;
          float4 kv[4], vv[4];
#pragma unroll
          for (int i = 0; i < 4; ++i) { kv[i] = key < NC ? ((const float4*)ksrc)[i] : make_float4(0.f, 0.f, 0.f, 0.f); vv[i] = key < NC ? ((const float4*)vsrc)[i] : make_float4(0.f, 0.f, 0.f, 0.f); }
#pragma unroll
          for (int c2 = 0; c2 < 2; ++c2) { const int ch = qtr * 2 + c2;
              const u32x4_t kw = {pk2(kv[2 * c2].x, kv[2 * c2].y), pk2(kv[2 * c2].z, kv[2 * c2].w), pk2(kv[2 * c2 + 1].x, kv[2 * c2 + 1].y), pk2(kv[2 * c2 + 1].z, kv[2 * c2 + 1].w)};
              const u32x4_t vw = {pk2(vv[2 * c2].x, vv[2 * c2].y), pk2(vv[2 * c2].z, vv[2 * c2].w), pk2(vv[2 * c2 + 1].x, vv[2 * c2 + 1].y), pk2(vv[2 * c2 + 1].z, vv[2 * c2 + 1].w)};
              *(LAS u32x4_t*)(L3 + CA_K + ch * 2048 + key * 16) = kw;
              *(LAS u32x4_t*)(L3 + CA_V + ((ch >> 2) * 8 + (key >> 4)) * 1024 + (key & 15) * 64 + (ch & 3) * 16) = vw; } }
        bf16x8_t qf[4];
        { const bf16_t* qp = cols + token * NCOL + C_QN + h * 64 + hi * 8;
#pragma unroll
          for (int d0 = 0; d0 < 4; ++d0) qf[d0] = *(const bf16x8_t*)(qp + 16 * d0); }
        const float gate = 1.f / (1.f + __expf(-bf2f(cols[token * NCOL + C_GATE + h * 3 + 0])));
        __syncthreads();
        __builtin_amdgcn_s_waitcnt(0);
        const LAS float* tabh = (const LAS float*)(L3 + CA_TAB) + h * 128;
        f32x16_t S[4] = {{}, {}, {}, {}};
#pragma unroll
        for (int kb = 0; kb < 4; ++kb)
#pragma unroll
            for (int d0 = 0; d0 < 4; ++d0) { const bf16x8_t kf = *(const LAS bf16x8_t*)(L3 + kfb + d0 * 4096 + kb * 512); S[kb] = __builtin_amdgcn_mfma_f32_32x32x16_bf16(kf, qf[d0], S[kb], 0, 0, 0); }
        float mx = -INFINITY;
#pragma unroll
        for (int kb = 0; kb < 4; ++kb) { float bb[16];
#pragma unroll
            for (int r = 0; r < 16; ++r) { const int c = 32 * kb + (r & 3) + 8 * (r >> 2) + 4 * hi; const int dist = tq - 16 * c - 31; bb[r] = tabh[dist < 0 ? 0 : (dist > 127 ? 127 : dist)]; }
            asm volatile("" : "+v"(bb[0]), "+v"(bb[1]), "+v"(bb[2]), "+v"(bb[3]), "+v"(bb[4]), "+v"(bb[5]), "+v"(bb[6]), "+v"(bb[7]), "+v"(bb[8]), "+v"(bb[9]), "+v"(bb[10]), "+v"(bb[11]), "+v"(bb[12]), "+v"(bb[13]), "+v"(bb[14]), "+v"(bb[15]));
#pragma unroll
            for (int r = 0; r < 16; ++r) { const int c = 32 * kb + (r & 3) + 8 * (r >> 2) + 4 * hi; const int dist = tq - 16 * c - 31;
                S[kb][r] = dist >= 0 ? S[kb][r] + bb[r] : -INFINITY; mx = fmaxf(mx, S[kb][r]); } }
        mx = fmaxf(mx, __shfl_xor(mx, 32));
        const float msafe = mx > -INFINITY ? mx : 0.f;
        float sum = 0.f;
#pragma unroll
        for (int kb = 0; kb < 4; ++kb)
#pragma unroll
            for (int r = 0; r < 16; ++r) { S[kb][r] = __builtin_amdgcn_exp2f(S[kb][r] - msafe); sum += S[kb][r]; }
        sum += __shfl_xor(sum, 32);
        const float inv = sum > 0.f ? 1.f / sum : 0.f;
#pragma unroll
        for (int kb = 0; kb < 4; ++kb)
#pragma unroll
            for (int r = 0; r < 16; ++r) S[kb][r] *= inv;
        if (qb >= 16) {
#pragma unroll
            for (int kb = 0; kb < 4; ++kb)
#pragma unroll
                for (int r = 0; r < 16; ++r) { float v = S[kb][r]; v += __builtin_bit_cast(float, __builtin_amdgcn_update_dpp(0, __builtin_bit_cast(int, v), 0xB1, 0xF, 0xF, false)); v += __builtin_bit_cast(float, __builtin_amdgcn_update_dpp(0, __builtin_bit_cast(int, v), 0x4E, 0xF, 0xF, false));
                    if (hr == 0) Ps[tloc * 128 + 32 * kb + (r & 3) + 8 * (r >> 2) + 4 * hi] = v; }
        }
        f32x16_t o0 = {}, o1 = {};
#pragma unroll
        for (int kg = 0; kg < 8; ++kg) {
            const int kb = kg >> 1, s = (kg & 1) * 8;
            const u32x4_t wv = {cvtpk_s(S[kb][s + 0], S[kb][s + 1]), cvtpk_s(S[kb][s + 2], S[kb][s + 3]), cvtpk_s(S[kb][s + 4], S[kb][s + 5]), cvtpk_s(S[kb][s + 6], S[kb][s + 7])};
            const bf16x8_t pf = __builtin_bit_cast(bf16x8_t, wv);
#pragma unroll
            for (int db = 0; db < 2; ++db) { const s16x4_t lo = lds_tr16(L3 + vfb + (db * 8 + kg) * 1024), hh = lds_tr16(L3 + vfb + (db * 8 + kg) * 1024 + 512);
                const bf16x8_t vf = {lo[0], lo[1], lo[2], lo[3], hh[0], hh[1], hh[2], hh[3]};
                if (db == 0) o0 = __builtin_amdgcn_mfma_f32_32x32x16_bf16(vf, pf, o0, 0, 0, 0); else o1 = __builtin_amdgcn_mfma_f32_32x32x16_bf16(vf, pf, o1, 0, 0, 0); } }
        { bf16_t* op = onsa + token * 512 + h * 64 + 4 * hi;
#pragma unroll
          for (int db = 0; db < 2; ++db)
#pragma unroll
              for (int q4 = 0; q4 < 4; ++q4) { const f32x16_t& oo = db ? o1 : o0; uint2* dst = (uint2*)(op + 32 * db + 8 * q4); const uint2 old = *dst;
                  uint2 w; w.x = cvtpk_s(blo(old.x) + gate * oo[4 * q4], bhi(old.x) + gate * oo[4 * q4 + 1]); w.y = cvtpk_s(blo(old.y) + gate * oo[4 * q4 + 2], bhi(old.y) + gate * oo[4 * q4 + 3]); *dst = w; } }
        if (qb < 16) {
            if (hr == 0 && hi == 0) WS(unsigned, W_SELM)[token * 2 + g] = (2u << qb) - 1u;
            __syncthreads();
        } else {
            __syncthreads();
#pragma unroll
            for (int i4 = 0; i4 < 4; ++i4) { const int idx = i4 * 512 + tid, tk = idx >> 5, j = idx & 31; const float* pp = Ps + tk * 128 + 4 * j;
                impS[idx] = (j > 0 ? pp[-1] : 0.f) + 2.f * (pp[0] + pp[1] + pp[2]) + pp[3]; }
            __syncthreads();
#pragma unroll
            for (int i4 = 0; i4 < 4; ++i4) { const int idx = i4 * 512 + tid, tk = idx >> 5, j = idx & 31; bool sel;
                if (j == 0 || j == qb || j == qb - 1) sel = true;
                else if (j > qb) sel = false;
                else { const float mi = impS[idx]; int rank = 0; const float* ip = impS + tk * 32;
                    for (int jj = 1; jj <= qb - 2; ++jj) { const float o = ip[jj]; rank += (o > mi) || (o == mi && jj < j); }
                    sel = rank < 13; }
                const unsigned long long bal = __ballot(sel);
                if (j == 0) WS(unsigned, W_SELM)[((size_t)b * 2048 + qb * 64 + tk) * 2 + g] = (unsigned)(bal >> (32 * hi)); }
            __syncthreads();
        }
    }
}
struct OneUnit { bool has; int pm;
    __device__ __forceinline__ bool next(int i, pg8::Unit& u) const { if (i != 0 || !has) return false; u.pm = pm; u.pn = 0; return true; }
    __device__ __forceinline__ void a_ready(const pg8::Unit&) const {}
    __device__ __forceinline__ void done(const pg8::Unit&) const {} };
struct EpiGelu { static constexpr bool PERM = true; static constexpr int NSTORE = 16;
    bf16_t* O; const float* bias;
    __device__ __forceinline__ void operator()(const pg8::f32x4 (&acc)[2][2][4][2], const pg8::Unit& u, int wr, int wc, int fr, int fq) const {
        const int row0 = u.pm * 256 + wr * 64 + fr, col0 = wc * 32 + 8 * fq;
#pragma unroll
        for (int ai = 0; ai < 2; ++ai)
#pragma unroll
            for (int m = 0; m < 4; ++m) { bf16_t* rowp = O + (size_t)(row0 + ai * 128 + m * 16) * 256 + col0;
#pragma unroll
                for (int bj = 0; bj < 2; ++bj) { float o[8];
#pragma unroll
                    for (int n = 0; n < 2; ++n)
#pragma unroll
                        for (int j = 0; j < 4; ++j) { const float x = acc[ai][bj][m][n][j] + bias[col0 + bj * 128 + 4 * n + j];
                            const float y = 0.7978845608028654f * (x + 0.044715f * x * x * x); const float e2 = __expf(2.f * y); const float th = 1.f - 2.f * __builtin_amdgcn_rcpf(e2 + 1.f);
                            o[n * 4 + j] = 0.5f * x * (1.f + th); }
                    pg8::u32x4 w; w.x = pg8::cvt_pk_bf16(o[0], o[1]); w.y = pg8::cvt_pk_bf16(o[2], o[3]); w.z = pg8::cvt_pk_bf16(o[4], o[5]); w.w = pg8::cvt_pk_bf16(o[6], o[7]);
                    *(pg8::u32x4*)(rowp + bj * 128) = w; } }
    }
};
__device__ __forceinline__ void ph_compress(const P& p, char* lds) {
    const bool has = blockIdx.x < 32; const int kv = blockIdx.x >> 4, pm = blockIdx.x & 15;
    if (!has) return;
    { pg8::Gemm g{WS(bf16_t, W_KCVB) + (size_t)kv * (16 * 2 * 2048 * 64), WS(bf16_t, kv ? W_W1VB : W_W1KB), 2048};
      OneUnit S{true, pm}; EpiGelu E{WS(bf16_t, W_H1B) + (size_t)kv * 4096 * 256, WS(float, W_BIAS1) + kv * 256};
      pg8::RowsDense AM{2048u};
      pg8::gemm_phase<EpiGelu, OneUnit, pg8::RowsDense, true>((PG8_LAS unsigned char*)lds, g, S, E, AM); }
    asm volatile("s_waitcnt vmcnt(0)" ::: "memory"); __threadfence_block(); __syncthreads();
    int tid_ = threadIdx.x; asm volatile("" : "+v"(tid_));
    const int lane = tid_ & 63, wid = tid_ >> 6, r32 = lane & 31, hi = lane >> 5;
    const bf16_t* hrow = WS(bf16_t, W_H1B) + ((size_t)kv * 4096 + pm * 256 + 32 * wid + r32) * 256 + 8 * hi;
    const bf16_t* w2t = WS(bf16_t, W_W2T) + (size_t)kv * 64 * 256 + (size_t)r32 * 256 + 8 * hi;
    f32x16_t c0 = {}, c1 = {};
#pragma unroll 4
    for (int k0 = 0; k0 < 16; ++k0) { const bf16x8_t a = *(const bf16x8_t*)(hrow + 16 * k0); const bf16x8_t b0 = *(const bf16x8_t*)(w2t + 16 * k0), b1 = *(const bf16x8_t*)(w2t + 32 * 256 + 16 * k0);
        c0 = __builtin_amdgcn_mfma_f32_32x32x16_bf16(a, b0, c0, 0, 0, 0); c1 = __builtin_amdgcn_mfma_f32_32x32x16_bf16(a, b1, c1, 0, 0, 0); }
    float* dstb = WS(float, kv ? W_VC : W_KC);
#pragma unroll
    for (int r = 0; r < 16; ++r) { const int m = pm * 256 + 32 * wid + (r & 3) + 8 * (r >> 2) + 4 * hi, bg = m >> 7, c = m & 127;
        if (c < NC) { float* d = dstb + ((size_t)((bg >> 1) * NC + c) * 2 + (bg & 1)) * 64 + r32; d[0] = c0[r]; d[32] = c1[r]; } }
}

struct WcItem { const float* src; unsigned char* dst; };
__device__ __forceinline__ WcItem wc_item(const P& p, int it, int lane) {
    constexpr int IPM = 16 * 32;
    const int mat = it / IPM, r = it % IPM, e = mat / 3, w = mat % 3, kb = r & 15, nb = r >> 4;
    const int k0 = 64 * kb, n0 = 32 * nb, n = n0 + (lane >> 1), hf = lane & 1;
    WcItem o;
    o.src = p.in[w == 0 ? 24 : (w == 1 ? 26 : 28)] + (size_t)e * 1048576 + (size_t)(k0 + (lane >> 5)) * 1024 + n0 + (lane & 31);
    const int row = w == 2 ? n : ((n >> 7) * 256 + w * 128 + (n & 127));
    o.dst = (w == 2 ? WS(unsigned char, W_WDN) + (size_t)e * 1024 * 1024 : WS(unsigned char, W_WGU) + (size_t)e * 2048 * 1024) + (size_t)row * 1024 + k0 + 32 * hf;
    return o;
}
#define WC_LOAD(WV, IT) do { const WcItem q_ = wc_item(p, (IT), lane); _Pragma("unroll") for (int i_ = 0; i_ < 32; ++i_) WV[i_] = q_.src[(size_t)i_ * 2048]; } while (0)
#define WC_FINISH(WV, IT) do { const WcItem q_ = wc_item(p, (IT), lane); \
        _Pragma("unroll") for (int i_ = 0; i_ < 32; ++i_) scr[(2 * i_ + (lane >> 5)) * 33 + (lane & 31)] = WV[i_] * WSCALE; \
        __builtin_amdgcn_fence(__ATOMIC_RELEASE, "wavefront"); asm volatile("s_waitcnt lgkmcnt(0)" ::: "memory"); \
        const float* s_ = scr + (32 * (lane & 1)) * 33 + (lane >> 1); uint4 o0_, o1_; \
        o0_.x = pk4_fp8(s_[0 * 33], s_[1 * 33], s_[2 * 33], s_[3 * 33]);     o0_.y = pk4_fp8(s_[4 * 33], s_[5 * 33], s_[6 * 33], s_[7 * 33]); \
        o0_.z = pk4_fp8(s_[8 * 33], s_[9 * 33], s_[10 * 33], s_[11 * 33]);   o0_.w = pk4_fp8(s_[12 * 33], s_[13 * 33], s_[14 * 33], s_[15 * 33]); \
        o1_.x = pk4_fp8(s_[16 * 33], s_[17 * 33], s_[18 * 33], s_[19 * 33]); o1_.y = pk4_fp8(s_[20 * 33], s_[21 * 33], s_[22 * 33], s_[23 * 33]); \
        o1_.z = pk4_fp8(s_[24 * 33], s_[25 * 33], s_[26 * 33], s_[27 * 33]); o1_.w = pk4_fp8(s_[28 * 33], s_[29 * 33], s_[30 * 33], s_[31 * 33]); \
        uint4* d_ = (uint4*)q_.dst; d_[0] = o0_; d_[1] = o1_; asm volatile("s_waitcnt lgkmcnt(0)" ::: "memory"); } while (0)
__device__ __forceinline__ void ph_wconv_experts(const P& p, char* lds) {
    int tid_ = threadIdx.x; asm volatile("" : "+v"(tid_));
    const int lane = tid_ & 63, wave = tid_ >> 6;
    float* scr = (float*)(lds + 32768 + wave * 8704);
    constexpr int NITEM = 96 * 16 * 32;
    int it0 = 0; if (lane == 0) it0 = (int)atomicAdd(WS(unsigned, W_QCTR) + 8, 8u);
    it0 = __builtin_amdgcn_readfirstlane(it0);
    if (it0 >= NITEM) return;
    float wa[32], wb[32];
    WC_LOAD(wa, it0);
    for (;;) {
        int itn = NITEM;
#pragma unroll
        for (int j = 0; j < 8; ++j) {
            if (j == 7) { if (lane == 0) itn = (int)atomicAdd(WS(unsigned, W_QCTR) + 8, 8u); itn = __builtin_amdgcn_readfirstlane(itn); }
            const int nx = j < 7 ? it0 + j + 1 : itn;
            if (j & 1) { if (nx < NITEM) WC_LOAD(wa, nx); WC_FINISH(wb, it0 + j); }
            else       { if (nx < NITEM) WC_LOAD(wb, nx); WC_FINISH(wa, it0 + j); }
        }
        if (itn >= NITEM) break;
        it0 = itn;
    }
}
#undef WC_LOAD
#undef WC_FINISH

__device__ __forceinline__ int moe_tiles(const P& p, int ch, int* tile_e  , int* row_start  ) {
    const int* cnt = WS(int, W_CNT) + ch * 32;
    __syncthreads();
    if (threadIdx.x == 0) { int t0 = 0;
        for (int e = 0; e < 32; ++e) { const int nt = (cnt[e] + 255) >> 8; row_start[e] = t0 * 256; for (int i = 0; i < nt; ++i) tile_e[t0 + i] = e; t0 += nt; }
        row_start[32] = t0; }
    __syncthreads();
    return row_start[32];
}
__device__ __forceinline__ void ph_scatter(const P& p, char* lds) {
    int* tile_e = (int*)(lds + 131072); int* row_start = (int*)(lds + 131072 + 4096);
    for (int ch = 0; ch < NCHUNK; ++ch) {
        (void)moe_tiles(p, ch, tile_e, row_start);
        int* rowtok = WS(int, W_ROWTOK) + ch * MAXROWS;
        for (int i = blockIdx.x * 512 + threadIdx.x; i < CHT * 4; i += gridDim.x * 512) {
            const int a = ch * CHT * 4 + i; const int e = WS(int, W_TOPE)[a]; const int prow = row_start[e] + WS(int, W_BBASE)[(((ch * CHT + (i >> 2)) >> 5) % (int)gridDim.x) * (NCHUNK * 32) + ch * 32 + e] + WS(int, W_POS)[a];
            rowtok[prow] = ch * CHT + (i >> 2); WS(int, W_AROW)[a] = prow; }
    }
}
struct MoeOrder { int nunit, npn_shift; const int* tile_e; int G, c;
    __device__ __forceinline__ bool next(int i, pg8::Unit& u) const { const int L = i * G + c; if (L >= nunit) return false; const int mt = L >> npn_shift; u.pm = mt; u.pn = (tile_e[mt] << npn_shift) + (L & ((1 << npn_shift) - 1)); return true; }
    __device__ __forceinline__ void a_ready(const pg8::Unit&) const {}
    __device__ __forceinline__ void done(const pg8::Unit&) const {} };
struct EpiAct { static constexpr bool PERM = true; static constexpr int NSTORE = 8;
    unsigned char* O; const float* bg; const float* bu;
    __device__ __forceinline__ void operator()(const pg8::f32x4 (&acc)[2][2][4][2], const pg8::Unit& u, int wr, int wc, int fr, int fq) const {
        const int e = u.pn >> 3, pnl = u.pn & 7; const int row0 = u.pm * 256 + wr * 64 + fr, col0 = pnl * 128 + wc * 32 + 8 * fq;
        pg8::f32x4 gb[2], ub[2];
#pragma unroll
        for (int n = 0; n < 2; ++n) { gb[n] = *(const pg8::f32x4*)(bg + e * 1024 + col0 + 4 * n); ub[n] = *(const pg8::f32x4*)(bu + e * 1024 + col0 + 4 * n); }
#pragma unroll
        for (int ai = 0; ai < 2; ++ai)
#pragma unroll
            for (int m = 0; m < 4; ++m) { float o[8];
#pragma unroll
                for (int n = 0; n < 2; ++n)
#pragma unroll
                    for (int j = 0; j < 4; ++j) { const float gt = fminf(fmaf(acc[ai][0][m][n][j], WSCALE_INV, gb[n][j]), 7.f); const float up = fminf(fmaxf(fmaf(acc[ai][1][m][n][j], WSCALE_INV, ub[n][j]), -7.f), 7.f);
                        o[n * 4 + j] = gt * __builtin_amdgcn_rcpf(1.f + __expf(-1.702f * gt)) * (up + 1.f); }
                uint2 w; w.x = pk4_fp8(o[0], o[1], o[2], o[3]); w.y = pk4_fp8(o[4], o[5], o[6], o[7]);
                *(uint2*)(O + (size_t)(row0 + ai * 128 + m * 16) * 1024 + col0) = w; }
    }
};
struct EpiDown { static constexpr bool PERM = true; static constexpr int NSTORE = 16;
    unsigned char* O; const float* bd;
    __device__ __forceinline__ void operator()(const pg8::f32x4 (&acc)[2][2][4][2], const pg8::Unit& u, int wr, int wc, int fr, int fq) const {
        const int e = u.pn >> 2, pnl = u.pn & 3; const int row0 = u.pm * 256 + wr * 64 + fr, col0 = pnl * 256 + wc * 32 + 8 * fq;
        pg8::f32x4 bv[2][2];
#pragma unroll
        for (int bj = 0; bj < 2; ++bj)
#pragma unroll
            for (int n = 0; n < 2; ++n) bv[bj][n] = *(const pg8::f32x4*)(bd + e * 1024 + col0 + bj * 128 + 4 * n);
#pragma unroll
        for (int ai = 0; ai < 2; ++ai)
#pragma unroll
            for (int m = 0; m < 4; ++m) { unsigned char* rowp = O + (size_t)(row0 + ai * 128 + m * 16) * 1024 + col0;
#pragma unroll
                for (int bj = 0; bj < 2; ++bj) { const pg8::f32x4 v0 = acc[ai][bj][m][0] * WSCALE_INV + bv[bj][0], v1 = acc[ai][bj][m][1] * WSCALE_INV + bv[bj][1];
                    uint2 w; w.x = pk4_fp8(v0[0], v0[1], v0[2], v0[3]); w.y = pk4_fp8(v1[0], v1[1], v1[2], v1[3]);
                    *(uint2*)(rowp + bj * 128) = w; } }
    }
};
struct EpiNone { static constexpr bool PERM = true; static constexpr int NSTORE = 0;
    __device__ __forceinline__ void operator()(const pg8::f32x4 (&acc)[2][2][4][2], const pg8::Unit& u, int wr, int wc, int fr, int fq) const {
        float s = 0.f;
#pragma unroll
        for (int ai = 0; ai < 2; ++ai)
#pragma unroll
            for (int bj = 0; bj < 2; ++bj)
#pragma unroll
                for (int mm = 0; mm < 4; ++mm)
#pragma unroll
                    for (int n = 0; n < 2; ++n) s += acc[ai][bj][mm][n][0] + acc[ai][bj][mm][n][1] + acc[ai][bj][mm][n][2] + acc[ai][bj][mm][n][3];
        if (s == 1.2345e30f) sink[0] = s; }
    float* sink; };
template <int CH, int VAR = 0>
__device__ __forceinline__ void ph_moe_gu(const P& p, char* lds) {
    int* tile_e = (int*)(lds + 131072); int* row_start = (int*)(lds + 131072 + 4096);
    const int ntile = moe_tiles(p, CH, tile_e, row_start);
    pg8::Gemm g{(const bf16_t*)WS(unsigned char, W_H2B), (const bf16_t*)WS(unsigned char, W_WGU), 512};
    MoeOrder S{ntile * 8, 3, tile_e, (int)gridDim.x, (int)blockIdx.x};
    pg8::RowsGather AM{WS(int, W_ROWTOK) + CH * MAXROWS, 1024u};
    if constexpr (VAR == 1) { EpiNone E{WS(float, W_BAR) + 16000}; pg8::gemm_phase<EpiNone, MoeOrder, pg8::RowsGather, true, 1>((PG8_LAS unsigned char*)lds, g, S, E, AM); }
    else { EpiAct E{WS(unsigned char, W_ACTB), p.in[25], p.in[27]}; pg8::gemm_phase<EpiAct, MoeOrder, pg8::RowsGather, true, 1>((PG8_LAS unsigned char*)lds, g, S, E, AM); }
}
struct RowsWrap { static constexpr bool DENSE = false; unsigned pitch;
    __device__ __forceinline__ unsigned off(int pm, int r) const { return (unsigned)((pm * 256 + r) & (T_ - 1)) * pitch; } };
template <int CH, int VAR = 0>
__device__ __forceinline__ void ph_moe_dn(const P& p, char* lds) {
    int* tile_e = (int*)(lds + 131072); int* row_start = (int*)(lds + 131072 + 4096);
    const int ntile = moe_tiles(p, CH, tile_e, row_start);
    MoeOrder S{ntile * 4, 2, tile_e, (int)gridDim.x, (int)blockIdx.x};
    if constexpr (VAR == 1) {
        pg8::Gemm g{(const bf16_t*)WS(unsigned char, W_ACTB), (const bf16_t*)WS(unsigned char, W_WDN), 512};
        EpiNone E{WS(float, W_BAR) + 16000}; pg8::RowsDenseL AM{1024u};
        pg8::gemm_phase<EpiNone, MoeOrder, pg8::RowsDenseL, true, 1>((PG8_LAS unsigned char*)lds, g, S, E, AM);
    } else if constexpr (VAR == 2) {
        pg8::Gemm g{(const bf16_t*)WS(unsigned char, W_H2B), (const bf16_t*)WS(unsigned char, W_WDN), 512};
        EpiDown E{WS(unsigned char, W_YPB), p.in[29]}; RowsWrap AM{1024u};
        pg8::gemm_phase<EpiDown, MoeOrder, RowsWrap, true, 1>((PG8_LAS unsigned char*)lds, g, S, E, AM);
    } else {
        pg8::Gemm g{(const bf16_t*)WS(unsigned char, W_ACTB), (const bf16_t*)WS(unsigned char, W_WDN), 512};
        EpiDown E{WS(unsigned char, W_YPB), p.in[29]}; pg8::RowsDenseL AM{1024u};
        pg8::gemm_phase<EpiDown, MoeOrder, pg8::RowsDenseL, false, 1>((PG8_LAS unsigned char*)lds, g, S, E, AM);
    }
}
template <int CH>
__device__ __forceinline__ void ph_final_fast(const P& p, float* outb, int ostride) {
    int tidL_ = threadIdx.x; asm volatile("" : "+v"(tidL_));
    const int lane = tidL_ & 63;
    const float* ada = WS(float, W_ADA);
    const unsigned char* yp = WS(unsigned char, W_YPB);
    for (int ul0 = (blockIdx.x * 8 + (tidL_ >> 6)) * 2; ul0 < CHT; ul0 += gridDim.x * 16) {
        int ar[2][4]; float tw[2][4];
#pragma unroll
        for (int tt = 0; tt < 2; ++tt)
#pragma unroll
            for (int k = 0; k < 4; ++k) { const int a = (CH * CHT + ul0 + tt) * 4 + k; ar[tt][k] = WS(int, W_AROW)[a]; tw[tt][k] = WS(float, W_TOPW)[a]; }
        int yv[2][4][4]; uint2 xb[2][4];
#pragma unroll
        for (int tt = 0; tt < 2; ++tt) { const bf16_t* xrow = WS(bf16_t, W_X1B) + (size_t)(CH * CHT + ul0 + tt) * 1024;
#pragma unroll
            for (int j = 0; j < 4; ++j) xb[tt][j] = *(const uint2*)(xrow + j * 256 + lane * 4);
#pragma unroll
            for (int k = 0; k < 4; ++k) { const unsigned char* yr = yp + (size_t)ar[tt][k] * 1024;
#pragma unroll
                for (int j = 0; j < 4; ++j) yv[tt][k][j] = *(const int*)(yr + j * 256 + lane * 4); } }
#pragma unroll
        for (int tt = 0; tt < 2; ++tt) {
            const int u = CH * CHT + ul0 + tt, b = u >> 11;
            float4 z[4]; float s = 0.f;
#pragma unroll
            for (int j = 0; j < 4; ++j) { float4 y = make_float4(0.f, 0.f, 0.f, 0.f);
#pragma unroll
                for (int k = 0; k < 4; ++k) { const f32x2_t lo = __builtin_amdgcn_cvt_pk_f32_fp8(yv[tt][k][j], false), hi2 = __builtin_amdgcn_cvt_pk_f32_fp8(yv[tt][k][j], true); const float w = tw[tt][k];
                    y.x += w * lo[0]; y.y += w * lo[1]; y.z += w * hi2[0]; y.w += w * hi2[1]; }
                const int c = j * 256 + lane * 4; const float4 xv = make_float4(blo(xb[tt][j].x), bhi(xb[tt][j].x), blo(xb[tt][j].y), bhi(xb[tt][j].y)); const float4 gv = *(const float4*)(ada + b * 6144 + 5120 + c);
                z[j] = make_float4(ALPHA * xv.x + (1.f + gv.x) * y.x, ALPHA * xv.y + (1.f + gv.y) * y.y, ALPHA * xv.z + (1.f + gv.z) * y.z, ALPHA * xv.w + (1.f + gv.w) * y.w);
                s += (z[j].x + z[j].y) + (z[j].z + z[j].w); }
            const float mu = wsum(s) * (1.f / 1024.f); float q = 0.f;
#pragma unroll
            for (int j = 0; j < 4; ++j) { z[j].x -= mu; z[j].y -= mu; z[j].z -= mu; z[j].w -= mu; q += (z[j].x * z[j].x + z[j].y * z[j].y) + (z[j].z * z[j].z + z[j].w * z[j].w); }
            const float rs = rsqrtf(wsum(q) * (1.f / 1024.f) + 1e-5f);
#pragma unroll
            for (int j = 0; j < 4; ++j) { const int c = j * 256 + lane * 4; const float4 gn = *(const float4*)(p.in[30] + c), bs = *(const float4*)(p.in[31] + c);
                *(float4*)(outb + (size_t)u * ostride + c) = make_float4(z[j].x * rs * gn.x + bs.x, z[j].y * rs * gn.y + bs.y, z[j].z * rs * gn.z + bs.z, z[j].w * rs * gn.w + bs.w); }
        }
    }
}

#ifndef PROBE
#define PROBE 0
#endif
constexpr int LDS_BYTES = 151552;
static_assert(MAXROWS / 256 * 4 <= 4096, "tile table");
__global__ void __launch_bounds__(512, 2) mega(P p) {
    extern __shared__ __attribute__((aligned(16))) char lds[];
    if (threadIdx.x == 0) { *(uint4*)(lds + LDS_BYTES - 16) = make_uint4(0u, 0u, 0u, 0u); }
    __syncthreads();
    XcdBarrier bar = xcd_barrier_post(WS(unsigned, W_BAR), (volatile LAS unsigned*)(lds + LDS_BYTES - 16));
#define RUN(id, ...) do { __VA_ARGS__; if (PROBE == (id)) { xcd_barrier(bar); __VA_ARGS__; } } while (0)
#define RUNX(id, first, ...) do { if (PROBE == (id)) { first; xcd_barrier(bar); } __VA_ARGS__; } while (0)
    bf16_t* const onsa = WS(bf16_t, W_ONSA); bf16_t* const dummy = WS(bf16_t, W_MIXB);
    RUN(1, ph_pre(p, lds)); ph_wconv_experts(p, lds);          xcd_barrier(bar);
    RUN(2, ph_hmod(p));                                       xcd_barrier(bar);
    RUN(3, ph_win(p, lds));                                   xcd_barrier(bar);
    RUNX(4, ph_nsa_attn<0>(p, lds, dummy, 1), ph_compress(p, lds); ph_prep(p); ph_nsa_attn<0>(p, lds, onsa, 0)); xcd_barrier(bar);
    RUNX(21, ph_dsa_index<3>(p, lds, (unsigned long long*)WS(float, W_MIXB)), (void)0);
    RUNX(22, ph_dsa_index<1>(p, lds, (unsigned long long*)WS(float, W_MIXB)), (void)0);
    RUNX(23, ph_dsa_index<2>(p, lds, (unsigned long long*)WS(float, W_MIXB)), (void)0);
    ph_dsa_index<3>(p, lds, WS(unsigned long long, W_DMASK));                             xcd_barrier(bar);
    RUNX(6, ph_nsa_cmp(p, lds, dummy), ph_nsa_cmp(p, lds, onsa)); RUN(7, ph_dsa_attn(p, lds)); xcd_barrier(bar);
    RUNX(8, ph_nsa_attn<1>(p, lds, dummy, 0), ph_nsa_attn<1>(p, lds, onsa, 0)); xcd_barrier(bar);
    RUN(9, ph_combine(p));                                    xcd_barrier(bar);
    RUN(10, ph_wout(p, lds));                                 xcd_barrier(bar);
    RUNX(18, ph_lnroute_fast<1>(p, lds, (bf16_t*)WS(float, W_COLS), (unsigned char*)WS(float, W_ONSA), WS(int, W_QCTR) + 64, (int*)WS(float, W_ODSA), WS(float, W_ODSA) + 262144, (int*)WS(float, W_ODSA) + 524288, (int*)WS(float, W_ODSA) + 1048576), (void)0);
    RUNX(19, ph_lnroute_fast<3>(p, lds, (bf16_t*)WS(float, W_COLS), (unsigned char*)WS(float, W_ONSA), WS(int, W_QCTR) + 64, (int*)WS(float, W_ODSA), WS(float, W_ODSA) + 262144, (int*)WS(float, W_ODSA) + 524288, (int*)WS(float, W_ODSA) + 1048576), (void)0);
    RUNX(15, ph_lnroute_fast<7>(p, lds, (bf16_t*)WS(float, W_COLS), (unsigned char*)WS(float, W_ONSA), WS(int, W_QCTR) + 64, (int*)WS(float, W_ODSA), WS(float, W_ODSA) + 262144, (int*)WS(float, W_ODSA) + 524288, (int*)WS(float, W_ODSA) + 1048576),
         ph_lnroute_fast<7>(p, lds, WS(bf16_t, W_X1B), WS(unsigned char, W_H2B), WS(int, W_CNT), WS(int, W_TOPE), WS(float, W_TOPW), WS(int, W_POS), WS(int, W_BBASE))); xcd_barrier(bar);
    RUN(17, ph_scatter(p, lds));    xcd_barrier(bar);
    RUNX(26, (ph_moe_gu<0, 1>(p, lds)), (void)0);
    RUN(12, ph_moe_gu<0>(p, lds));                            xcd_barrier(bar);
    RUNX(24, (ph_moe_dn<0, 1>(p, lds)), (void)0); RUNX(25, (ph_moe_dn<0, 2>(p, lds)), (void)0);
    RUN(13, ph_moe_dn<0>(p, lds));                            xcd_barrier(bar);
    ph_final_fast<0>(p, p.out, 1024);
    if (PROBE == 14) { for (int i = 0; i < 10; ++i) xcd_barrier(bar); }
}
}

extern "C" void kernel_launch(void* const* d_in, const int* in_sizes, int n_in, void* d_out, int out_size, void* d_ws, size_t ws_size, hipStream_t stream) {
    P p{};
    for (int i = 0; i < 32; ++i) p.in[i] = (const float*)d_in[i];
    p.out = (float*)d_out; p.ws = (unsigned char*)d_ws;
    static int grid = 0;
    if (!grid) {
        int dev = 0, cus = 0, per_cu = 0;
        (void)hipGetDevice(&dev);
        (void)hipDeviceGetAttribute(&cus, hipDeviceAttributeMultiprocessorCount, dev);
        (void)hipFuncSetAttribute((const void*)mega, hipFuncAttributeMaxDynamicSharedMemorySize, LDS_BYTES);
        (void)hipOccupancyMaxActiveBlocksPerMultiprocessor(&per_cu, mega, 512, LDS_BYTES);
        grid = cus * (per_cu < 1 ? per_cu : 1);
        if (grid <= 0) grid = 256;
    }
    (void)hipMemsetAsync(d_ws, 0, 65536, stream);
    (void)hipMemsetAsync((char*)d_ws + W_ROWTOK, 0, (size_t)NCHUNK * MAXROWS * 4, stream);
    mega<<<grid, 512, LDS_BYTES, stream>>>(p);
}
```

```cpp
#include <hip/hip_runtime.h>
#include <stdint.h>
#include <cstdio>

namespace {
constexpr int B_ = 16, S_ = 2048, D_ = 1024, T_ = B_ * S_;
constexpr int INC = 2528;
constexpr int NCOL = 2560;
constexpr int O_GATE = 1280, O_QD = 1304;
constexpr int C_QN = 0, C_KC = 512, C_VC = 640, C_KS = 768, C_VS = 896, C_KW = 1024, C_VW = 1152, C_QD = 1280, C_CKV = 1792, C_QI = 1920, C_KI = 2432, C_GATE = 2496, C_WI = 2520;
constexpr int NC = 127, NCR = B_ * NC * 2;
constexpr int NCHUNK = 1, CHT = T_ / NCHUNK;
constexpr int MAXROWS = CHT * 4 + 32 * 256;
constexpr float ALPHA = 1.189207115002721f;
constexpr size_t MiB = 1u << 20;
constexpr size_t W_BAR = 0;
constexpr size_t W_CNT = 32768;
constexpr size_t W_ADA = 1 * MiB;
constexpr size_t W_TOPE = 2 * MiB, W_TOPW = 2 * MiB + 512 * 1024, W_POS = 3 * MiB, W_AROW = 3 * MiB + 512 * 1024;
constexpr size_t W_ROWTOK = 4 * MiB;
constexpr size_t W_SELM = 5 * MiB;
constexpr size_t W_WUKB = 5 * MiB + 256 * 1024;
constexpr size_t W_WUVT = 5 * MiB + 512 * 1024;
constexpr size_t W_BBASE = 5 * MiB + 768 * 1024;
constexpr size_t W_WOUTB = 6 * MiB;
constexpr size_t W_WINB = 8 * MiB;
constexpr size_t W_W1KB = 13 * MiB, W_W1VB = 14 * MiB;
constexpr size_t W_BIAS1 = 57344;
constexpr size_t W_W2T = 15 * MiB + 65536;
constexpr size_t W_WGU = 16 * MiB;
constexpr size_t W_WDN = 80 * MiB;
constexpr size_t W_COLS = 112 * MiB;
constexpr size_t W_KCVB = 272 * MiB;
constexpr size_t W_ONSA = 292 * MiB;
constexpr size_t W_YB = 292 * MiB;
constexpr size_t W_ODSA = 356 * MiB;
constexpr size_t W_HB = 356 * MiB;
constexpr size_t W_MIXB = 420 * MiB;
constexpr size_t W_DMASK = 484 * MiB;
constexpr size_t W_CKVN = 492 * MiB;
constexpr size_t W_KILN = 500 * MiB;
constexpr size_t W_KC = 504 * MiB, W_VC = 505 * MiB;
constexpr size_t W_H1B = 506 * MiB;
constexpr size_t W_H1K = 520 * MiB, W_H1V = 525 * MiB;
constexpr size_t W_QCTR = 49152;
constexpr size_t W_H2B = 112 * MiB;
constexpr size_t W_ACTB = 144 * MiB;
constexpr size_t W_X1B = 416 * MiB;
constexpr size_t W_YPB = 280 * MiB;

__constant__ unsigned char c_bucket[128] = {
    0, 1, 2, 3, 4, 5, 6, 7, 8, 9, 10, 11, 12, 13, 14, 15, 16, 16, 16, 17, 17, 18, 18, 18, 19, 19, 19, 20, 20, 20, 20, 21,
    21, 21, 21, 22, 22, 22, 22, 22, 23, 23, 23, 23, 23, 23, 24, 24, 24, 24, 24, 24, 25, 25, 25, 25, 25, 25, 25, 26, 26, 26, 26, 26,
    26, 26, 26, 27, 27, 27, 27, 27, 27, 27, 27, 27, 27, 28, 28, 28, 28, 28, 28, 28, 28, 28, 28, 29, 29, 29, 29, 29, 29, 29, 29, 29,
    29, 29, 29, 30, 30, 30, 30, 30, 30, 30, 30, 30, 30, 30, 30, 30, 30, 31, 31, 31, 31, 31, 31, 31, 31, 31, 31, 31, 31, 31, 31, 31};
__device__ __forceinline__ int bucket(int d) { return d >= 128 ? 31 : (int)c_bucket[d]; }

__device__ __forceinline__ float dppf(float v, const int ctrl_unused) { return v; }
__device__ __forceinline__ float wsum(float v) {
    v += __builtin_bit_cast(float, __builtin_amdgcn_update_dpp(0, __builtin_bit_cast(int, v), 0xB1, 0xF, 0xF, false));
    v += __builtin_bit_cast(float, __builtin_amdgcn_update_dpp(0, __builtin_bit_cast(int, v), 0x4E, 0xF, 0xF, false));
    v += __builtin_bit_cast(float, __builtin_amdgcn_update_dpp(0, __builtin_bit_cast(int, v), 0x141, 0xF, 0xF, false));
    v += __builtin_bit_cast(float, __builtin_amdgcn_update_dpp(0, __builtin_bit_cast(int, v), 0x140, 0xF, 0xF, false));
    const int iv = __builtin_bit_cast(int, v);
    return (__builtin_bit_cast(float, __builtin_amdgcn_readlane(iv, 0)) + __builtin_bit_cast(float, __builtin_amdgcn_readlane(iv, 16))) + (__builtin_bit_cast(float, __builtin_amdgcn_readlane(iv, 32)) + __builtin_bit_cast(float, __builtin_amdgcn_readlane(iv, 48)));
}
__device__ __forceinline__ unsigned wor_dpp(unsigned x) {
    int v = (int)x;
    v |= __builtin_amdgcn_update_dpp(0, v, 0xB1, 0xF, 0xF, false);
    v |= __builtin_amdgcn_update_dpp(0, v, 0x4E, 0xF, 0xF, false);
    v |= __builtin_amdgcn_update_dpp(0, v, 0x141, 0xF, 0xF, false);
    v |= __builtin_amdgcn_update_dpp(0, v, 0x140, 0xF, 0xF, false);
    return (unsigned)(__builtin_amdgcn_readlane(v, 0) | __builtin_amdgcn_readlane(v, 16) | __builtin_amdgcn_readlane(v, 32) | __builtin_amdgcn_readlane(v, 48));
}
__device__ __forceinline__ float xch32f(float v) { const auto rr = __builtin_amdgcn_permlane32_swap(__float_as_uint(v), __float_as_uint(v), false, false); return (threadIdx.x & 32) ? __uint_as_float(rr[0]) : __uint_as_float(rr[1]); }
__device__ __forceinline__ float wmax(float v) { for (int o = 32; o > 0; o >>= 1) v = fmaxf(v, __shfl_xor(v, o)); return v; }
__device__ __forceinline__ int wsumi(int v) { for (int o = 32; o > 0; o >>= 1) v += __shfl_xor(v, o); return v; }

typedef unsigned short bf16_t;
__device__ __forceinline__ unsigned f2bf(float f) { unsigned u = __float_as_uint(f); return (u + 0x7fffu + ((u >> 16) & 1u)) >> 16; }
__device__ __forceinline__ unsigned pk2(float lo, float hi) { typedef float f2_ __attribute__((ext_vector_type(2))); typedef __bf16 b2_ __attribute__((ext_vector_type(2))); const f2_ v = {lo, hi}; return __builtin_bit_cast(unsigned, __builtin_convertvector(v, b2_)); }
__device__ __forceinline__ float bf2f(unsigned short v) { return __uint_as_float((unsigned)v << 16); }
__device__ __forceinline__ unsigned pk4_fp8(float a, float b, float c, float d) { int v = __builtin_amdgcn_cvt_pk_fp8_f32(a, b, 0, false); v = __builtin_amdgcn_cvt_pk_fp8_f32(c, d, v, true); return (unsigned)v; }
__device__ __forceinline__ float blo(unsigned v) { return __uint_as_float(v << 16); }
__device__ __forceinline__ float bhi(unsigned v) { return __uint_as_float(v & 0xffff0000u); }

struct P {
    const float* in[32];
    float* out;
    unsigned char* ws;
};
#define WS(T, off) ((T*)(p.ws + (off)))

namespace pg8 {
#define PG8_LAS __attribute__((address_space(3)))
typedef unsigned short bf16_t;
typedef short bf16x8 __attribute__((ext_vector_type(8)));
typedef float f32x4 __attribute__((ext_vector_type(4)));
typedef float f32x2 __attribute__((ext_vector_type(2)));
typedef unsigned u32x4 __attribute__((ext_vector_type(4)));
typedef int i32x4 __attribute__((ext_vector_type(4)));
typedef int i32x8 __attribute__((ext_vector_type(8)));
constexpr int BM = 256, BK = 64, HALF = 128, HTB = HALF * BK * 2, STAGE_BYTES = 8 * HTB;
__device__ __forceinline__ int lds_byte(int r, int c) { const int st = (r >> 4) * 2 + (c >> 5), rr = r & 15, cc = c & 31, ob = rr * 64 + cc * 2; return st * 1024 + (ob ^ (((ob >> 9) & 1) << 5)); }
__device__ __forceinline__ void stage_rc(int b, int& R, int& C) { const int st = b / 1024, sb = b % 1024, swz = sb ^ (((sb >> 9) & 1) << 5); R = (st >> 1) * 16 + swz / 64; C = (st & 1) * 32 + (swz % 64) / 2; }
__device__ __forceinline__ int perm32(int rho) { const int n = rho >> 4, i = rho & 15; return 8 * (i >> 2) + 4 * n + (i & 3); }
struct Unit { int pm, pn; };
struct Gemm { const bf16_t* A; const bf16_t* Bt; int K; };
__device__ __forceinline__ unsigned cvt_pk_bf16(float lo, float hi) { unsigned r; asm volatile("v_cvt_pk_bf16_f32 %0, %1, %2" : "=v"(r) : "v"(lo), "v"(hi)); return r; }
struct RowsDense { static constexpr bool DENSE = true; unsigned pitch;
    __device__ __forceinline__ unsigned off(int pm, int r) const { return (unsigned)(pm * BM + r) * pitch; } };
struct RowsDenseL { static constexpr bool DENSE = false; unsigned pitch;
    __device__ __forceinline__ unsigned off(int pm, int r) const { return (unsigned)(pm * BM + r) * pitch; } };
struct RowsGather { static constexpr bool DENSE = false; const int* rowtok; unsigned pitch;
    __device__ __forceinline__ unsigned off(int pm, int r) const { return (unsigned)rowtok[pm * BM + r] * pitch; } };

template <class Epi, class Sched, class AMap, bool ALIGN_EPI, int MK = 0  >
__device__ __forceinline__ void gemm_phase(PG8_LAS unsigned char* lds, const Gemm g, const Sched& S, const Epi& E, const AMap& AM) {
    int tid_ = threadIdx.x; asm volatile("" : "+v"(tid_));
    const int tid = tid_, wid = __builtin_amdgcn_readfirstlane(tid >> 6), lane = tid & 63, wr = wid >> 2, wc = wid & 3, fr = lane & 15, fq = lane >> 4;
    const int K = g.K, nt = K / BK;
    unsigned voffB[2], ca2[2]; int ra[2];
#pragma unroll
    for (int i = 0; i < 2; ++i) { int R, C; stage_rc(tid * 16 + i * 8192, R, C); const int Rb = Epi::PERM ? ((R & ~31) + perm32(R & 31)) : R;
        ra[i] = R; ca2[i] = (unsigned)C * 2u; voffB[i] = (unsigned)(Rb * K + C) * 2u; }
    const size_t kstep = (size_t)(BK * 2);
    const size_t hstep = (size_t)HALF * K * 2;
    const size_t tstep = 2 * hstep;
    const unsigned ldsw = (unsigned)wid * 1024u;
    const int aoff = lds_byte(wr * 64 + fr, fq * 8), boff = lds_byte(wc * 32 + fr, fq * 8);
    const char* Ab = (const char*)g.A;
#define PG8_SA(b, h) (((b) * 2 + (h)) * HTB)
#define PG8_SB(b, h) ((4 + (b) * 2 + (h)) * HTB)
#define PG8_STAGE(bufoff, gbase, voff) do { _Pragma("unroll") for (int _i = 0; _i < 2; ++_i) \
        __builtin_amdgcn_global_load_lds((const unsigned*)((const char*)(gbase) + (voff)[_i]), (PG8_LAS unsigned*)(lds + (bufoff) + ldsw + _i * 8192), 16, 0, 0); } while (0)
#define PG8_LDA(dst, b, h) do { _Pragma("unroll") for (int m = 0; m < 4; ++m) _Pragma("unroll") for (int k = 0; k < 2; ++k) dst[m][k] = *(const PG8_LAS bf16x8*)(lds + PG8_SA(b, h) + aoff + m * 2048 + k * 1024); } while (0)
#define PG8_LDB(dst, b, h) do { _Pragma("unroll") for (int n = 0; n < 2; ++n) _Pragma("unroll") for (int k = 0; k < 2; ++k) dst[n][k] = *(const PG8_LAS bf16x8*)(lds + PG8_SB(b, h) + boff + n * 2048 + k * 1024); } while (0)
#define PG8_MMA(ai, bj, At, Bt) do { __builtin_amdgcn_s_setprio(1); _Pragma("unroll") for (int m = 0; m < 4; ++m) _Pragma("unroll") for (int n = 0; n < 2; ++n) { \
        if constexpr (MK == 0) { _Pragma("unroll") for (int k = 0; k < 2; ++k) acc[ai][bj][m][n] = __builtin_amdgcn_mfma_f32_16x16x32_bf16(Bt[n][k], At[m][k], acc[ai][bj][m][n], 0, 0, 0); } \
        else { const i32x8 b8_ = __builtin_shufflevector(__builtin_bit_cast(i32x4, Bt[n][0]), __builtin_bit_cast(i32x4, Bt[n][1]), 0, 1, 2, 3, 4, 5, 6, 7); \
               const i32x8 a8_ = __builtin_shufflevector(__builtin_bit_cast(i32x4, At[m][0]), __builtin_bit_cast(i32x4, At[m][1]), 0, 1, 2, 3, 4, 5, 6, 7); \
               acc[ai][bj][m][n] = __builtin_amdgcn_mfma_scale_f32_16x16x128_f8f6f4(b8_, a8_, acc[ai][bj][m][n], 0, 0, 0, 0, 0, 0); } }   \
        __builtin_amdgcn_s_setprio(0); } while (0)
#define PG8_WAIT_V(n) asm volatile("s_waitcnt vmcnt(" #n ")" ::: "memory")
#define PG8_WAIT_L(n) asm volatile("s_waitcnt lgkmcnt(" #n ")" ::: "memory")
#define PG8_BAR __builtin_amdgcn_s_barrier()
#define PG8_SCHED __builtin_amdgcn_sched_barrier(0)
    Unit cur, nxt; int ui = 0;
    if (!S.next(0, cur)) return;
#define PG8_WAIT_V1() do { if constexpr (Epi::NSTORE == 16) asm volatile("s_waitcnt vmcnt(24)\n\ts_cmp_lg_u32 %0, 0\n\ts_cbranch_scc1 1f\n\ts_waitcnt vmcnt(8)\n1:" :: "s"(fe) : "memory", "scc"); \
        else if constexpr (Epi::NSTORE == 8) asm volatile("s_waitcnt vmcnt(16)\n\ts_cmp_lg_u32 %0, 0\n\ts_cbranch_scc1 1f\n\ts_waitcnt vmcnt(8)\n1:" :: "s"(fe) : "memory", "scc"); \
        else asm volatile("s_waitcnt vmcnt(8)" ::: "memory"); } while (0)
    int after_epi = 0;
    f32x4 acc[2][2][4][2];
#pragma unroll
    for (int a = 0; a < 2; ++a)
#pragma unroll
        for (int b = 0; b < 2; ++b)
#pragma unroll
            for (int m = 0; m < 4; ++m)
#pragma unroll
                for (int n = 0; n < 2; ++n) acc[a][b][m][n] = (f32x4){0.f, 0.f, 0.f, 0.f};
    bf16x8 At[4][2], B0[2][2], B1[2][2];
    unsigned ov0[2], ov1[2], nv0[2], nv1[2];
    const char* uA = Ab; const char* nA = Ab;
    if constexpr (AMap::DENSE) {
#pragma unroll
        for (int i = 0; i < 2; ++i) { ov0[i] = AM.off(0, ra[i]) + ca2[i]; ov1[i] = AM.off(0, HALF + ra[i]) + ca2[i]; }
        uA = Ab + (size_t)AM.off(cur.pm, 0);
    } else {
#pragma unroll
        for (int i = 0; i < 2; ++i) { ov0[i] = AM.off(cur.pm, ra[i]) + ca2[i]; ov1[i] = AM.off(cur.pm, HALF + ra[i]) + ca2[i]; }
    }
    const char* cB = (const char*)g.Bt + (size_t)cur.pn * tstep;
    S.a_ready(cur);
    PG8_STAGE(PG8_SB(0, 0), cB, voffB); PG8_STAGE(PG8_SB(0, 1), cB + hstep, voffB); PG8_STAGE(PG8_SA(0, 0), uA, ov0); PG8_STAGE(PG8_SA(0, 1), uA, ov1);
    if (wr == 1) PG8_BAR;
    PG8_WAIT_V(2); PG8_BAR;
    PG8_STAGE(PG8_SB(1, 0), cB + kstep, voffB); PG8_STAGE(PG8_SA(1, 0), uA + kstep, ov0); PG8_STAGE(PG8_SB(1, 1), cB + hstep + kstep, voffB);
    PG8_WAIT_V(6); PG8_BAR;
    PG8_STAGE(PG8_SA(1, 1), uA + kstep, ov1);
    for (;;) {
        const bool has_next = S.next(ui + 1, nxt);
        const char* nB = has_next ? (const char*)g.Bt + (size_t)nxt.pn * tstep : cB;
        if constexpr (AMap::DENSE) { nA = has_next ? Ab + (size_t)AM.off(nxt.pm, 0) : uA; }
        else {
#pragma unroll
            for (int i = 0; i < 2; ++i) { nv0[i] = has_next ? AM.off(nxt.pm, ra[i]) + ca2[i] : ov0[i]; nv1[i] = has_next ? AM.off(nxt.pm, HALF + ra[i]) + ca2[i] : ov1[i]; }
        }
#pragma unroll 1
        for (int t = 0; t < nt; t += 2) {
            const bool last = (t == nt - 2);
            const int fe = __builtin_amdgcn_readfirstlane(t == 0 ? after_epi : 0);
            const char* a1 = uA + (size_t)(t + 1) * kstep;
            const char* a2 = last ? nA : uA + (size_t)(t + 2) * kstep; const char* b2 = last ? nB : cB + (size_t)(t + 2) * kstep;
            const char* a3 = a2 + kstep; const char* b3 = b2 + kstep;
            if (last && has_next) S.a_ready(nxt);
            PG8_LDB(B0, 0, 0); PG8_LDB(B1, 0, 1); PG8_SCHED; PG8_LDA(At, 0, 0);
            if constexpr (!AMap::DENSE) { if (last) {
_Pragma("unroll") for (int i = 0; i < 2; ++i) { ov0[i] = nv0[i]; ov1[i] = nv1[i]; } } }
            PG8_WAIT_V1(); PG8_WAIT_L(0); PG8_BAR; PG8_MMA(0, 0, At, B0); PG8_MMA(0, 1, At, B1); PG8_BAR; PG8_SCHED;
            PG8_LDA(At, 0, 1); PG8_STAGE(PG8_SB(0, 0), b2, voffB); PG8_STAGE(PG8_SB(0, 1), b2 + hstep, voffB); PG8_STAGE(PG8_SA(0, 0), a2, ov0);
            PG8_WAIT_V1(); PG8_WAIT_L(0); PG8_BAR; PG8_MMA(1, 0, At, B0); PG8_MMA(1, 1, At, B1); PG8_BAR; PG8_SCHED;
            PG8_LDB(B0, 1, 0); PG8_LDB(B1, 1, 1); PG8_SCHED; PG8_LDA(At, 1, 0); PG8_STAGE(PG8_SA(0, 1), a2, ov1);
            PG8_WAIT_V1(); PG8_WAIT_L(0); PG8_BAR; PG8_MMA(0, 0, At, B0); PG8_MMA(0, 1, At, B1); PG8_BAR; PG8_SCHED;
            PG8_LDA(At, 1, 1); PG8_STAGE(PG8_SB(1, 0), b3, voffB); PG8_STAGE(PG8_SB(1, 1), b3 + hstep, voffB); PG8_STAGE(PG8_SA(1, 0), a3, ov0);
            PG8_WAIT_V(8); PG8_WAIT_L(0); PG8_BAR; PG8_MMA(1, 0, At, B0); PG8_MMA(1, 1, At, B1); PG8_BAR; PG8_SCHED;
            PG8_STAGE(PG8_SA(1, 1), a3, ov1);
        }
        after_epi = 1;
        if constexpr (ALIGN_EPI) { if (wr == 0) PG8_BAR; }
        E(acc, cur, wr, wc, fr, fq); S.done(cur);
        if (!has_next) break;
#pragma unroll
        for (int a = 0; a < 2; ++a)
#pragma unroll
            for (int b = 0; b < 2; ++b)
#pragma unroll
                for (int m = 0; m < 4; ++m)
#pragma unroll
                    for (int n = 0; n < 2; ++n) acc[a][b][m][n] = (f32x4){0.f, 0.f, 0.f, 0.f};
        cur = nxt; cB = nB; uA = nA; ++ui;
        if constexpr (ALIGN_EPI) { if (wr == 1) PG8_BAR; }
    }
    PG8_WAIT_V(0);
    if constexpr (!ALIGN_EPI) { if (wr == 0) PG8_BAR; }
    PG8_BAR;
#undef PG8_SA
#undef PG8_SB
#undef PG8_STAGE
#undef PG8_LDA
#undef PG8_LDB
#undef PG8_MMA
#undef PG8_WAIT_V
#undef PG8_WAIT_V1
#undef PG8_WAIT_L
#undef PG8_BAR
#undef PG8_SCHED
}
}

#define XB_TMO      128
#define XB_XCNT(j)  (256  + 64 * (j))
#define XB_XSUB(j)  (1280 + 64 * (j))
#define XB_XGEN(j)  (2304 + 64 * (j))
#define XB_TOP      3328
#define XB_TOPGEN   3392
#define XCD_BAR_WORDS 3456
#define XB_SPIN_CAP (1u << 18)
#define LAS __attribute__((address_space(3)))
__device__ __forceinline__ float4 ldnt4(const float* p) { typedef float f4n_ __attribute__((ext_vector_type(4))); const f4n_ t = __builtin_nontemporal_load((const f4n_*)p); return make_float4(t[0], t[1], t[2], t[3]); }
__device__ __forceinline__ uint2 ldnt2(const void* p) { typedef unsigned u2n_ __attribute__((ext_vector_type(2))); const u2n_ t = __builtin_nontemporal_load((const u2n_*)p); return make_uint2(t[0], t[1]); }
#define LDS_BARRIER() asm volatile("s_waitcnt lgkmcnt(0)\n\ts_barrier" ::: "memory")
__device__ __forceinline__ unsigned xb_ld(unsigned* p)              { return __hip_atomic_load(p, __ATOMIC_RELAXED, __HIP_MEMORY_SCOPE_AGENT); }
__device__ __forceinline__ unsigned xb_add(unsigned* p, unsigned v) { return __hip_atomic_fetch_add(p, v, __ATOMIC_RELAXED, __HIP_MEMORY_SCOPE_AGENT); }
__device__ __forceinline__ unsigned xb_xcc_id() { return (unsigned)__builtin_amdgcn_s_getreg((3 << 11) | 20) & 0xFu; }
#define XB_SPIN(cond, bar) do { unsigned _sp = 0; while (cond) { __builtin_amdgcn_s_sleep(1); \
    if ((++_sp & 255u) == 0u) { if (xb_ld(&(bar)[XB_TMO])) break; if (_sp > XB_SPIN_CAP) { atomicAdd(&(bar)[XB_TMO], 1u); break; } } } } while (0)
struct XcdBarrier { unsigned* bar; unsigned x; volatile LAS unsigned* st; };
__device__ __forceinline__ XcdBarrier xcd_barrier_post(unsigned* bar, volatile LAS unsigned* st) {
    XcdBarrier b; b.bar = bar; b.x = xb_xcc_id(); b.st = st;
    if (threadIdx.x == 0) (void)xb_add(&bar[XB_XCNT(b.x)], 1u);
    return b;
}
__device__ __forceinline__ void xcd_barrier_complete(unsigned* bar, unsigned x, unsigned& nloc, unsigned& nx) {
    const unsigned G = gridDim.x * gridDim.y * gridDim.z;
    unsigned sum, cnt, mine, sp = 0u;
    for (;;) {
        sum = 0u; cnt = 0u; mine = 0u;
#pragma unroll
        for (unsigned j = 0; j < 16; ++j) { const unsigned c = xb_ld(&bar[XB_XCNT(j)]); sum += c; cnt += (c > 0u) ? 1u : 0u; mine = (j == x) ? c : mine; }
        if (sum == G) break;
        __builtin_amdgcn_s_sleep(1);
        if ((++sp & 255u) == 0u) { if (xb_ld(&bar[XB_TMO])) break; if (sp > XB_SPIN_CAP) { atomicAdd(&bar[XB_TMO], 1u); break; } }
    }
    nloc = mine > 0u ? mine : 1u; nx = cnt > 0u ? cnt : 1u;
}
__device__ __forceinline__ void xcd_barrier(const XcdBarrier& b) {
    asm volatile("s_waitcnt vmcnt(0)" ::: "memory");
    __syncthreads();
    if (threadIdx.x == 0) {
        unsigned* bar = b.bar;
        __builtin_amdgcn_s_waitcnt(0);
        unsigned nloc = b.st[0], nx = b.st[1];
        if (nloc == 0u) { xcd_barrier_complete(bar, b.x, nloc, nx); b.st[0] = nloc; b.st[1] = nx; }
        const unsigned old = xb_add(&bar[XB_XSUB(b.x)], 1u);
        const unsigned gen = old / nloc;
        if (old + 1u == (gen + 1u) * nloc) {
            __builtin_amdgcn_fence(__ATOMIC_RELEASE, "agent");
            asm volatile("s_waitcnt vmcnt(0)" ::: "memory");
            const unsigned og = xb_add(&bar[XB_TOP], 1u);
            const unsigned tg = og / nx;
            if (og + 1u == (tg + 1u) * nx) xb_add(&bar[XB_TOPGEN], 1u);
            else XB_SPIN(xb_ld(&bar[XB_TOPGEN]) == tg, bar);
            __builtin_amdgcn_fence(__ATOMIC_ACQUIRE, "agent");
            xb_add(&bar[XB_XGEN(b.x)], 1u);
            asm volatile("s_waitcnt vmcnt(0)" ::: "memory");
        } else {
            XB_SPIN(xb_ld(&bar[XB_XGEN(b.x)]) == gen, bar);
            __builtin_amdgcn_fence(__ATOMIC_ACQUIRE, "agent");
            asm volatile("s_waitcnt vmcnt(0)" ::: "memory");
        }
    }
    __syncthreads();
}

template <class RowMap>
__device__ __forceinline__ void transpose_item(const float* W, int ldw, int K, bf16_t* WT, const RowMap& rm, float* scr, int kb, int nb, int lane) {
    const int k0 = 64 * kb, n0 = 32 * nb;
#pragma unroll 8
    for (int i = 0; i < 32; ++i) { const int kk = 2 * i + (lane >> 5); scr[kk * 33 + (lane & 31)] = __builtin_nontemporal_load(W + (size_t)(k0 + kk) * ldw + n0 + (lane & 31)); }
    __builtin_amdgcn_fence(__ATOMIC_RELEASE, "wavefront"); asm volatile("s_waitcnt lgkmcnt(0)" ::: "memory");
    const int c = lane & 7;
#pragma unroll
    for (int j = 0; j < 4; ++j) { const int n = (lane >> 3) + 8 * j; const float* s = scr + (8 * c) * 33 + n;
        uint4 o; o.x = pk2(s[0 * 33], s[1 * 33]); o.y = pk2(s[2 * 33], s[3 * 33]); o.z = pk2(s[4 * 33], s[5 * 33]); o.w = pk2(s[6 * 33], s[7 * 33]);
        *(uint4*)(WT + (size_t)rm(n0 + n) * K + k0 + 8 * c) = o; }
    asm volatile("s_waitcnt lgkmcnt(0)" ::: "memory");
}
struct RM_ident { int off; __device__ __forceinline__ int operator()(int n) const { return off + n; } };
struct RM_gu { int mtx; __device__ __forceinline__ int operator()(int f) const { return (f >> 7) * 256 + mtx * 128 + (f & 127); } };
struct RM_win { __device__ __forceinline__ int operator()(int n) const { return n < O_GATE ? n : (n < O_QD ? C_GATE + (n - O_GATE) : (n < 2520 ? n - 24 : n)); } };

constexpr float WSCALE = 64.f, WSCALE_INV = 1.f / 64.f;
template <class RowMap>
__device__ __forceinline__ void transpose_item_f8(const float* W, int ldw, int K, unsigned char* WT, const RowMap& rm, float* scr, int kb, int nb, int lane) {
    const int k0 = 64 * kb, n0 = 32 * nb;
    float wv[32];
#pragma unroll
    for (int i = 0; i < 32; ++i) wv[i] = __builtin_nontemporal_load(W + (size_t)(k0 + 2 * i + (lane >> 5)) * ldw + n0 + (lane & 31));
#pragma unroll
    for (int i = 0; i < 32; ++i) scr[(2 * i + (lane >> 5)) * 33 + (lane & 31)] = wv[i] * WSCALE;
    __builtin_amdgcn_fence(__ATOMIC_RELEASE, "wavefront"); asm volatile("s_waitcnt lgkmcnt(0)" ::: "memory");
    const int n = lane >> 1, hf = lane & 1; const float* s = scr + (32 * hf) * 33 + n;
    uint4 o0, o1;
    o0.x = pk4_fp8(s[0 * 33], s[1 * 33], s[2 * 33], s[3 * 33]);     o0.y = pk4_fp8(s[4 * 33], s[5 * 33], s[6 * 33], s[7 * 33]);
    o0.z = pk4_fp8(s[8 * 33], s[9 * 33], s[10 * 33], s[11 * 33]);   o0.w = pk4_fp8(s[12 * 33], s[13 * 33], s[14 * 33], s[15 * 33]);
    o1.x = pk4_fp8(s[16 * 33], s[17 * 33], s[18 * 33], s[19 * 33]); o1.y = pk4_fp8(s[20 * 33], s[21 * 33], s[22 * 33], s[23 * 33]);
    o1.z = pk4_fp8(s[24 * 33], s[25 * 33], s[26 * 33], s[27 * 33]); o1.w = pk4_fp8(s[28 * 33], s[29 * 33], s[30 * 33], s[31 * 33]);
    uint4* d = (uint4*)(WT + (size_t)rm(n0 + n) * K + k0 + 32 * hf); d[0] = o0; d[1] = o1;
    asm volatile("s_waitcnt lgkmcnt(0)" ::: "memory");
}
__device__ __forceinline__ void ph_pre(const P& p, char* lds) {
    { const int lane = threadIdx.x & 63, wave = threadIdx.x >> 6;
      float* scr = (float*)(lds + 32768 + wave * 8704);
      const int gw = ((int)gridDim.x - 1 - (int)blockIdx.x) * 8 + wave, NGW = gridDim.x * 8;
      constexpr int I_IN = 16 * 79, I_OUT = 16 * 32, I_W1 = 32 * 8;
      for (int it = gw; it < I_IN + I_OUT + 32 + 2 * I_W1; it += NGW) {
          if (it >= I_IN + I_OUT + 32) { const int r = it - (I_IN + I_OUT + 32), kv = r / I_W1, q = r % I_W1; transpose_item(p.in[kv ? 9 : 6], 256, 2048, WS(bf16_t, kv ? W_W1VB : W_W1KB), RM_ident{0}, scr, q >> 3, q & 7, lane); continue; }
          if (it < I_IN) transpose_item(p.in[4], INC, 1024, WS(bf16_t, W_WINB), RM_win{}, scr, it / 79, it % 79, lane);
          else if (it < I_IN + I_OUT) { const int r = it - I_IN; transpose_item_f8(p.in[19], 1024, 1024, WS(unsigned char, W_WOUTB), RM_ident{0}, scr, r >> 5, r & 31, lane); }
          else { const int r = it - I_IN - I_OUT; uint4* z = (uint4*)(WS(bf16_t, W_WINB) + (size_t)(INC + r) * 1024); z[lane] = make_uint4(0u, 0u, 0u, 0u); z[lane + 64] = make_uint4(0u, 0u, 0u, 0u); } } }
    if (blockIdx.x + 16 >= gridDim.x) { const int kb = (int)(blockIdx.x + 16 - gridDim.x); const int kv = threadIdx.x >> 8, n = threadIdx.x & 255; const float* w1 = p.in[kv ? 9 : 6]; const float* pos = p.in[kv ? 8 : 5]; float a = 0.f;
#pragma unroll 16
        for (int k = kb * 128; k < kb * 128 + 128; ++k) a += pos[k] * w1[(size_t)k * 256 + n];
        atomicAdd(WS(float, W_BIAS1) + kv * 256 + n, a); }
    for (int i = blockIdx.x * 512 + threadIdx.x; i < NCHUNK * MAXROWS; i += gridDim.x * 512) WS(int, W_ROWTOK)[i] = 0;
    for (int i = blockIdx.x * 512 + threadIdx.x; i < 2 * 64 * 256; i += gridDim.x * 512) { const int kv = i >> 14, n = (i >> 8) & 63, k = i & 255; WS(bf16_t, W_W2T)[i] = (bf16_t)f2bf(p.in[kv ? 10 : 7][k * 64 + n]); }
    for (int i = blockIdx.x * 512 + threadIdx.x; i < 65536; i += gridDim.x * 512) { WS(bf16_t, W_WUKB)[i] = (bf16_t)f2bf(p.in[14][i]);
        const int hh = i >> 13, d = (i >> 7) & 63, c = i & 127; WS(bf16_t, W_WUVT)[i] = (bf16_t)f2bf(p.in[15][(size_t)(hh * 128 + c) * 64 + d]); }
    if (blockIdx.x < 96) {
        float* sl = (float*)lds;
        float* red = (float*)(lds + 65536);
        const int tid = threadIdx.x, jl = tid & 63, kg = tid >> 6;
        __syncthreads();
        for (int i = tid; i < 16384; i += 512) { const int b = i >> 10, k = i & 1023; const float v = p.in[1][i]; sl[k * 16 + b] = v / (1.f + expf(-v)); }
        __syncthreads();
        for (int u = blockIdx.x; u < 96; u += gridDim.x) {
            const int j = u * 64 + jl; const float* w = p.in[2] + j;
            float acc[16];
#pragma unroll
            for (int b = 0; b < 16; ++b) acc[b] = 0.f;
#pragma unroll 16
            for (int k = kg * 128; k < kg * 128 + 128; ++k) { const float wv = __builtin_nontemporal_load(w + (size_t)k * 6144); const float4* s4 = (const float4*)(sl + k * 16);
                const float4 s0 = s4[0], s1 = s4[1], s2 = s4[2], s3 = s4[3];
                acc[0] += s0.x * wv; acc[1] += s0.y * wv; acc[2] += s0.z * wv; acc[3] += s0.w * wv; acc[4] += s1.x * wv; acc[5] += s1.y * wv; acc[6] += s1.z * wv; acc[7] += s1.w * wv;
                acc[8] += s2.x * wv; acc[9] += s2.y * wv; acc[10] += s2.z * wv; acc[11] += s2.w * wv; acc[12] += s3.x * wv; acc[13] += s3.y * wv; acc[14] += s3.z * wv; acc[15] += s3.w * wv; }
#pragma unroll
            for (int b = 0; b < 16; ++b) red[(kg * 16 + b) * 64 + jl] = acc[b];
            __syncthreads();
            for (int o = tid; o < 1024; o += 512) { const int b = o >> 6, jj = o & 63; float a = p.in[3][u * 64 + jj];
#pragma unroll
                for (int g8 = 0; g8 < 8; ++g8) a += red[(g8 * 16 + b) * 64 + jj];
                WS(float, W_ADA)[b * 6144 + u * 64 + jj] = a; }
            __syncthreads();
        }
    }
}
__device__ __forceinline__ void ph_hmod(const P& p) {
    const int lane = threadIdx.x & 63; const float* ada = WS(float, W_ADA);
    constexpr int RPI = 8;
    for (int u0 = (blockIdx.x * 8 + (threadIdx.x >> 6)) * RPI; u0 < T_; u0 += gridDim.x * 8 * RPI) {
        float4 xv[RPI][4];
#pragma unroll
        for (int i = 0; i < RPI; ++i)
#pragma unroll
            for (int j = 0; j < 4; ++j) xv[i][j] = ldnt4(p.in[0] + (size_t)(u0 + i) * 1024 + j * 256 + lane * 4);
        const int b = u0 >> 11;
#pragma unroll
        for (int j = 0; j < 4; ++j) { const int c = j * 256 + lane * 4; const float4 sh = *(const float4*)(ada + b * 6144 + c), sc = *(const float4*)(ada + b * 6144 + 1024 + c);
#pragma unroll
            for (int i = 0; i < RPI; ++i) { bf16_t* hr = WS(bf16_t, W_HB) + (size_t)(u0 + i) * 1024; const float4 x = xv[i][j];
                uint2 o; o.x = pk2(x.x * (1.f + sc.x) + sh.x, x.y * (1.f + sc.y) + sh.y); o.y = pk2(x.z * (1.f + sc.z) + sh.z, x.w * (1.f + sc.w) + sh.w);
                *(uint2*)(hr + c) = o; } }
    }
}
struct StaticOrder {
    int nM, nN, nwg, G, c;
    __device__ __forceinline__ void init(int M, int N, int G_, int c_) { nM = M / 256; nN = N / 256; nwg = nM * nN; G = G_; c = c_; }
    __device__ __forceinline__ bool next(int i, pg8::Unit& u) const {
        const long L = (long)i * G + c; if (L >= nwg) return false;
        int wgid = (int)L; { const int q = nwg / 8, r = nwg % 8, xcd = wgid % 8, off = wgid / 8; wgid = (xcd < r ? xcd * (q + 1) : r * (q + 1) + (xcd - r) * q) + off; }
        const int nig = 8 * nN, gid = wgid / nig, fm = gid * 8, gsz = (nM - fm) < 8 ? (nM - fm) : 8;
        u.pm = fm + ((wgid % nig) % gsz); u.pn = (wgid % nig) / gsz; return true;
    }
    __device__ __forceinline__ void a_ready(const pg8::Unit&) const {}
    __device__ __forceinline__ void done(const pg8::Unit&) const {}
};
struct EpiCols { static constexpr bool PERM = true; static constexpr int NSTORE = 16;
    bf16_t* O; bf16_t* KCV;
    __device__ __forceinline__ void operator()(const pg8::f32x4 (&acc)[2][2][4][2], const pg8::Unit& u, int wr, int wc, int fr, int fq) const {
        const int row0 = u.pm * 256 + wr * 64 + fr;
        const float qs = (u.pn == 0 || u.pn == 1 || u.pn == 5 || u.pn == 6) ? 0.125f * 1.4426950408889634f : 1.f;
#pragma unroll
        for (int ai = 0; ai < 2; ++ai)
#pragma unroll
            for (int m = 0; m < 4; ++m) { const int row = row0 + ai * 128 + m * 16;
#pragma unroll
                for (int bj = 0; bj < 2; ++bj) { const pg8::f32x4 v0 = acc[ai][bj][m][0] * qs, v1 = acc[ai][bj][m][1] * qs;
                    pg8::u32x4 w; w.x = pg8::cvt_pk_bf16(v0[0], v0[1]); w.y = pg8::cvt_pk_bf16(v0[2], v0[3]); w.z = pg8::cvt_pk_bf16(v1[0], v1[1]); w.w = pg8::cvt_pk_bf16(v1[2], v1[3]);
                    if (u.pn == 2) { const int b = row >> 11, t = row & 2047, g = wc >> 1, d = 32 * (wc & 1) + 8 * fq;
                        *(pg8::u32x4*)(KCV + ((size_t)((bj * 16 + b) * 2 + g) * 2048 + t) * 64 + d) = w; }
                    else *(pg8::u32x4*)(O + (size_t)row * NCOL + u.pn * 256 + bj * 128 + wc * 32 + 8 * fq) = w; } }
    }
};
__device__ __forceinline__ void ph_win(const P& p, char* lds) {
    pg8::Gemm g{WS(bf16_t, W_HB), WS(bf16_t, W_WINB), 1024};
    StaticOrder S; S.init(T_, NCOL, (int)gridDim.x, (int)blockIdx.x);
    EpiCols E{WS(bf16_t, W_COLS), WS(bf16_t, W_KCVB)};
    pg8::RowsDense AM{2048u};
    pg8::gemm_phase<EpiCols, StaticOrder, pg8::RowsDense, true>((PG8_LAS unsigned char*)lds, g, S, E, AM);
}
struct EpiY { static constexpr bool PERM = true; static constexpr int NSTORE = 16;
    bf16_t* O;
    __device__ __forceinline__ void operator()(const pg8::f32x4 (&acc)[2][2][4][2], const pg8::Unit& u, int wr, int wc, int fr, int fq) const {
        const int row0 = u.pm * 256 + wr * 64 + fr, col0 = u.pn * 256 + wc * 32 + 8 * fq;
#pragma unroll
        for (int ai = 0; ai < 2; ++ai)
#pragma unroll
            for (int m = 0; m < 4; ++m) { bf16_t* rowp = O + (size_t)(row0 + ai * 128 + m * 16) * 1024 + col0;
#pragma unroll
                for (int bj = 0; bj < 2; ++bj) { const pg8::f32x4 v0 = acc[ai][bj][m][0] * WSCALE_INV, v1 = acc[ai][bj][m][1] * WSCALE_INV;
                    pg8::u32x4 w; w.x = pg8::cvt_pk_bf16(v0[0], v0[1]); w.y = pg8::cvt_pk_bf16(v0[2], v0[3]); w.z = pg8::cvt_pk_bf16(v1[0], v1[1]); w.w = pg8::cvt_pk_bf16(v1[2], v1[3]);
                    *(pg8::u32x4*)(rowp + bj * 128) = w; } }
    }
};
__device__ __forceinline__ void ph_wout(const P& p, char* lds) {
    pg8::Gemm g{(const bf16_t*)WS(unsigned char, W_MIXB), (const bf16_t*)WS(unsigned char, W_WOUTB), 512};
    StaticOrder S; S.init(T_, 1024, (int)gridDim.x, (int)blockIdx.x);
    EpiY E{WS(bf16_t, W_YB)};
    pg8::RowsDenseL AM{1024u};
    pg8::gemm_phase<EpiY, StaticOrder, pg8::RowsDenseL, true, 1>((PG8_LAS unsigned char*)lds, g, S, E, AM);
}

__device__ __forceinline__ void ph_prep(const P& p) {
    const int lane = threadIdx.x & 63;
    constexpr int TPI = 4;
    for (int tok0 = (blockIdx.x * 8 + (threadIdx.x >> 6)) * TPI; tok0 < T_; tok0 += gridDim.x * 8 * TPI) {
        unsigned short r0[TPI], r1[TPI], r2[TPI];
#pragma unroll
        for (int i = 0; i < TPI; ++i) { const bf16_t* crow = WS(bf16_t, W_COLS) + (size_t)(tok0 + i) * NCOL; r0[i] = crow[C_CKV + lane]; r1[i] = crow[C_CKV + 64 + lane]; r2[i] = crow[C_KI + lane]; }
        const float g0 = p.in[11][lane], g1 = p.in[11][64 + lane], kg = p.in[12][lane], kb = p.in[13][lane];
#pragma unroll
        for (int i = 0; i < TPI; ++i) { const int tok = tok0 + i;
            const float a0 = bf2f(r0[i]), a1 = bf2f(r1[i]);
            const float ss = wsum(a0 * a0 + a1 * a1);
            const float r = rsqrtf(ss * (1.f / 128.f) + 1e-6f);
            bf16_t* ck = WS(bf16_t, W_CKVN) + (size_t)tok * 128;
            ck[lane] = (bf16_t)f2bf(a0 * r * g0); ck[64 + lane] = (bf16_t)f2bf(a1 * r * g1);
            const float kv = bf2f(r2[i]);
            const float mu = wsum(kv) * (1.f / 64.f);
            const float dv = kv - mu;
            const float var = wsum(dv * dv) * (1.f / 64.f);
            WS(bf16_t, W_KILN)[(size_t)tok * 64 + lane] = (bf16_t)f2bf(dv * rsqrtf(var + 1e-5f) * kg + kb); }
    }
}

__device__ __forceinline__ unsigned ukey(float f) { const unsigned u = __float_as_uint(f); return (u & 0x80000000u) ? ~u : (u | 0x80000000u); }
__device__ __forceinline__ void ph_combine(const P& p) {
    const int lane = threadIdx.x & 63;
#pragma unroll 2
    for (int u = blockIdx.x * 8 + (threadIdx.x >> 6); u < T_; u += gridDim.x * 8) {
        unsigned char* mr = WS(unsigned char, W_MIXB) + (size_t)u * 1024;
#pragma unroll
        for (int half = 0; half < 2; ++half) { const bf16_t* src = (half ? WS(bf16_t, W_ODSA) : WS(bf16_t, W_ONSA)) + (size_t)u * 512; const float* gn = p.in[half ? 17 : 16];
            const uint2 ab = ldnt2(src + lane * 4), cb = ldnt2(src + 256 + lane * 4);
            const float4 a = make_float4(blo(ab.x), bhi(ab.x), blo(ab.y), bhi(ab.y)), c = make_float4(blo(cb.x), bhi(cb.x), blo(cb.y), bhi(cb.y));
            const float ss = wsum((a.x * a.x + a.y * a.y) + (a.z * a.z + a.w * a.w) + (c.x * c.x + c.y * c.y) + (c.z * c.z + c.w * c.w));
            const float r = rsqrtf(ss * (1.f / 512.f) + 1e-6f);
            const float4 g0 = *(const float4*)(gn + lane * 4), g1 = *(const float4*)(gn + 256 + lane * 4);
            *(unsigned*)(mr + half * 512 + lane * 4) = pk4_fp8(a.x * r * g0.x, a.y * r * g0.y, a.z * r * g0.z, a.w * r * g0.w);
            *(unsigned*)(mr + half * 512 + 256 + lane * 4) = pk4_fp8(c.x * r * g1.x, c.y * r * g1.y, c.z * r * g1.z, c.w * r * g1.w); }
    }
}
typedef short bf16x8_t __attribute__((ext_vector_type(8)));
typedef short s16x4_t __attribute__((ext_vector_type(4)));
typedef float f32x16_t __attribute__((ext_vector_type(16)));
typedef unsigned u32x4_t __attribute__((ext_vector_type(4)));
typedef float f32x2_t __attribute__((ext_vector_type(2))); typedef __bf16 bf16x2v_t __attribute__((ext_vector_type(2)));
__device__ __forceinline__ unsigned cvtpk_s(float lo, float hi) { const f32x2_t v = {lo, hi}; const bf16x2v_t b = __builtin_convertvector(v, bf16x2v_t); return __builtin_bit_cast(unsigned, b); }
constexpr float LOG2E = 1.4426950408889634f;
constexpr float C2S = 0.125f * LOG2E;
constexpr int AT_K = 0, AT_V = 16384, AT_TAB = 32768, AT_MISC = 40960;
__device__ __forceinline__ s16x4_t lds_tr16(LAS char* p) { return __builtin_bit_cast(s16x4_t, __builtin_amdgcn_ds_read_tr16_b64_v4i16((LAS s16x4_t*)p)); }
__device__ __forceinline__ void attn_fill_tab(const P& p, char* lds) {
    float* tab = (float*)(lds + AT_TAB);
    for (int i = threadIdx.x; i < 16 * 128; i += 512) tab[i] = p.in[18][bucket(i & 127) * 16 + (i >> 7)] * LOG2E;
    __syncthreads();
}
template <int MODE  >
__device__ __forceinline__ void ph_nsa_attn(const P& p, char* lds, bf16_t* onsa, int qslot) {
    int tid_ = threadIdx.x; asm volatile("" : "+v"(tid_));
    const int tid = tid_, lane = tid & 63, wid = __builtin_amdgcn_readfirstlane(tid >> 6), r32 = lane & 31, hi = lane >> 5, hr = wid & 3, th = wid >> 2;
    const unsigned lbase = (unsigned)(uintptr_t)lds;
    LAS char* L3 = (LAS char*)lds;
    const bf16_t* cols = WS(bf16_t, W_COLS);
    const LAS float* tab = (const LAS float*)(L3 + AT_TAB);
    unsigned* um_p = (unsigned*)(lds + AT_MISC);
    constexpr int CK = MODE == 0 ? C_KW : C_KS, CV = MODE == 0 ? C_VW : C_VS;
    const int skey = tid >> 3, sch = tid & 7;
    const unsigned kdst = AT_K + sch * 1024 + skey * 16, vdst = AT_V + ((sch >> 2) * 4 + (skey >> 4)) * 1024 + (skey & 15) * 64 + (sch & 3) * 16;
    const unsigned kfb = AT_K + hi * 1024 + r32 * 16;
    const unsigned vfb = AT_V + (4 * hi + ((lane & 15) >> 2)) * 64 + ((lane >> 4) & 1) * 32 + (lane & 3) * 8;
    attn_fill_tab(p, lds);
    for (int it = 0; it < 1024; ++it) {
        int vc;
        if (MODE == 0) { if (tid == 0) um_p[2] = atomicAdd(WS(unsigned, W_QCTR) + qslot, 1u); LDS_BARRIER(); vc = (int)um_p[2]; LDS_BARRIER(); }
        else vc = (int)blockIdx.x + it * (int)gridDim.x;
        if (vc >= 1024) break;
        const int cu = vc % 256, rep = vc / 256, bg = MODE == 1 ? 4 * (cu & 7) + (cu >> 6) : cu >> 3, s8 = MODE == 1 ? (cu >> 3) & 7 : cu & 7;
        const int qb = rep == 0 ? s8 : rep == 1 ? 15 - s8 : rep == 2 ? 16 + s8 : 31 - s8;
        const int b = bg >> 1, g = bg & 1, h = g * 4 + hr;
        const int tq = qb * 64 + th * 32 + r32; const size_t token = (size_t)b * 2048 + tq;
        const bf16_t* kvbase = cols + (size_t)b * 2048 * NCOL + g * 64;
        bf16x8_t qf[4];
        { const bf16_t* qp = cols + token * NCOL + C_QN + h * 64 + hi * 8;
#pragma unroll
          for (int d0 = 0; d0 < 4; ++d0) qf[d0] = *(const bf16x8_t*)(qp + 16 * d0); }
        const float gate = 1.f / (1.f + __expf(-bf2f(cols[token * NCOL + C_GATE + h * 3 + (MODE == 0 ? 2 : 1)])));
        unsigned mym = 0xffffffffu, um;
        if (MODE == 1) {
            mym = WS(unsigned, W_SELM)[token * 2 + g];
            const unsigned w = wor_dpp(mym);
            if (tid == 0) *um_p = 0u;
            LDS_BARRIER();
            if (lane == 0) atomicOr(um_p, w);
            LDS_BARRIER();
            um = *um_p;
        } else { const int lo = qb - 8 < 0 ? 0 : qb - 8; um = (qb == 31 ? 0xffffffffu : ((1u << (qb + 1)) - 1u)) & ~((1u << lo) - 1u); }
        um = (unsigned)__builtin_amdgcn_readfirstlane((int)um);
        unsigned wm = mym;
        if (MODE == 1) wm = wor_dpp(mym);
        const LAS float* tabh = tab + h * 128; const float bfar = tabh[127];
        float m_run = -1e30f, l_run = 0.f; f32x16_t o0 = {}, o1 = {};
        int cur = __builtin_ctz(um); um &= um - 1u;
        u32x4_t kreg, vreg;
        { const bf16_t* src = kvbase + (size_t)(cur * 64 + skey) * NCOL + sch * 8; kreg = *(const u32x4_t*)(src + CK); vreg = *(const u32x4_t*)(src + CV); }
        *(LAS u32x4_t*)(L3 + kdst) = kreg; *(LAS u32x4_t*)(L3 + vdst) = vreg;
        __syncthreads();
        __builtin_amdgcn_s_waitcnt(0);
        int buf = 0;
        for (;;) {
            const int nxt = um ? __builtin_ctz(um) : -1; um &= um - 1u;
            if (nxt >= 0) { const bf16_t* src = kvbase + (size_t)(nxt * 64 + skey) * NCOL + sch * 8; kreg = *(const u32x4_t*)(src + CK); vreg = *(const u32x4_t*)(src + CV); }
            if (MODE == 0 || ((wm >> cur) & 1u)) {
                const unsigned kb_ = kfb + buf * 8192, vb_ = vfb + buf * 8192;
                const int kbase = cur * 64;
                const int dmin = (qb * 64 + th * 32) - (kbase + 63), dmax = (qb * 64 + th * 32 + 31) - kbase;
                const bool slow = (dmin < 128) || (MODE == 0 && dmax >= 512);
                const float c0 = slow ? 0.f : bfar;
                f32x16_t p0 = {c0, c0, c0, c0, c0, c0, c0, c0, c0, c0, c0, c0, c0, c0, c0, c0}, p1 = p0;
#pragma unroll
                for (int d0 = 0; d0 < 4; ++d0) {
                    const bf16x8_t k0 = *(const LAS bf16x8_t*)(L3 + kb_ + d0 * 2048);
                    const bf16x8_t k1 = *(const LAS bf16x8_t*)(L3 + kb_ + d0 * 2048 + 512);
                    p0 = __builtin_amdgcn_mfma_f32_32x32x16_bf16(k0, qf[d0], p0, 0, 0, 0);
                    p1 = __builtin_amdgcn_mfma_f32_32x32x16_bf16(k1, qf[d0], p1, 0, 0, 0); }
                if (slow) {
                    const int dq = tq - kbase - 4 * hi; const bool selq = (MODE == 0) || ((mym >> cur) & 1u);
                    float b0[16], b1[16];
#pragma unroll
                    for (int r = 0; r < 16; ++r) { const int c = (r & 3) + 8 * (r >> 2); const int d0_ = dq - c, d1_ = dq - c - 32;
                        b0[r] = tabh[d0_ < 0 ? 0 : (d0_ > 127 ? 127 : d0_)]; b1[r] = tabh[d1_ < 0 ? 0 : (d1_ > 127 ? 127 : d1_)]; }
                    asm volatile("" : "+v"(b0[0]), "+v"(b0[1]), "+v"(b0[2]), "+v"(b0[3]), "+v"(b0[4]), "+v"(b0[5]), "+v"(b0[6]), "+v"(b0[7]), "+v"(b0[8]), "+v"(b0[9]), "+v"(b0[10]), "+v"(b0[11]), "+v"(b0[12]), "+v"(b0[13]), "+v"(b0[14]), "+v"(b0[15]));
                    asm volatile("" : "+v"(b1[0]), "+v"(b1[1]), "+v"(b1[2]), "+v"(b1[3]), "+v"(b1[4]), "+v"(b1[5]), "+v"(b1[6]), "+v"(b1[7]), "+v"(b1[8]), "+v"(b1[9]), "+v"(b1[10]), "+v"(b1[11]), "+v"(b1[12]), "+v"(b1[13]), "+v"(b1[14]), "+v"(b1[15]));
#pragma unroll
                    for (int r = 0; r < 16; ++r) { const int c = (r & 3) + 8 * (r >> 2); const int d0_ = dq - c, d1_ = dq - c - 32;
                        const bool ok0 = selq && d0_ >= 0 && (MODE != 0 || d0_ < 512), ok1 = selq && d1_ >= 0 && (MODE != 0 || d1_ < 512);
                        p0[r] = ok0 ? p0[r] + b0[r] : -INFINITY; p1[r] = ok1 ? p1[r] + b1[r] : -INFINITY; }
                } else {
                    if (MODE == 1) { const bool selq = (mym >> cur) & 1u;
#pragma unroll
                        for (int r = 0; r < 16; ++r) { p0[r] = selq ? p0[r] : -INFINITY; p1[r] = selq ? p1[r] : -INFINITY; } }
                }
                float mx = p0[0];
#pragma unroll
                for (int r = 0; r < 16; ++r) { if (r) mx = fmaxf(mx, p0[r]); mx = fmaxf(mx, p1[r]); }
                { const auto rr = __builtin_amdgcn_permlane32_swap(__float_as_uint(mx), __float_as_uint(mx), false, false); mx = fmaxf(__uint_as_float(rr[0]), __uint_as_float(rr[1])); }
                const float m_new = fmaxf(m_run, mx);
                const float alpha = __builtin_amdgcn_exp2f(m_run - m_new);
                m_run = m_new;
                float rs = 0.f;
#pragma unroll
                for (int r = 0; r < 16; ++r) { p0[r] = __builtin_amdgcn_exp2f(p0[r] - m_new); p1[r] = __builtin_amdgcn_exp2f(p1[r] - m_new); rs += p0[r] + p1[r]; }
                l_run = l_run * alpha + rs;
                if (__ballot(alpha != 1.f)) {
#pragma unroll
                    for (int r = 0; r < 16; ++r) { o0[r] *= alpha; o1[r] *= alpha; } }
#pragma unroll
                for (int ks = 0; ks < 4; ++ks) {
                    bf16x8_t pf;
                    { const f32x16_t& pp = (ks < 2) ? p0 : p1; const int s = (ks & 1) * 8;
                      const unsigned w0 = cvtpk_s(pp[s + 0], pp[s + 1]), w1 = cvtpk_s(pp[s + 2], pp[s + 3]), w2 = cvtpk_s(pp[s + 4], pp[s + 5]), w3 = cvtpk_s(pp[s + 6], pp[s + 7]);
                      const uint4 wv = make_uint4(w0, w1, w2, w3); pf = __builtin_bit_cast(bf16x8_t, wv); }
#pragma unroll
                    for (int db = 0; db < 2; ++db) {
                        const s16x4_t lo = lds_tr16(L3 + vb_ + (db * 4 + ks) * 1024), hh = lds_tr16(L3 + vb_ + (db * 4 + ks) * 1024 + 512);
                        const bf16x8_t vf = {lo[0], lo[1], lo[2], lo[3], hh[0], hh[1], hh[2], hh[3]};
                        if (db == 0) o0 = __builtin_amdgcn_mfma_f32_32x32x16_bf16(vf, pf, o0, 0, 0, 0); else o1 = __builtin_amdgcn_mfma_f32_32x32x16_bf16(vf, pf, o1, 0, 0, 0); }
                }
            }
            if (nxt >= 0) { *(LAS u32x4_t*)(L3 + kdst + (buf ^ 1) * 8192) = kreg; *(LAS u32x4_t*)(L3 + vdst + (buf ^ 1) * 8192) = vreg; }
            __syncthreads();
            if (nxt < 0) break;
            cur = nxt; buf ^= 1;
        }
        float l_tot; { const auto rr = __builtin_amdgcn_permlane32_swap(__float_as_uint(l_run), __float_as_uint(l_run), false, false); l_tot = __uint_as_float(rr[0]) + __uint_as_float(rr[1]); }
        const float sc = l_tot > 0.f ? gate / l_tot : 0.f;
        bf16_t* op = onsa + token * 512 + h * 64 + 4 * hi;
#pragma unroll
        for (int db = 0; db < 2; ++db)
#pragma unroll
            for (int q4 = 0; q4 < 4; ++q4) { const f32x16_t& oo = db ? o1 : o0; uint2* dst = (uint2*)(op + 32 * db + 8 * q4);
                float4 v = make_float4(oo[4 * q4] * sc, oo[4 * q4 + 1] * sc, oo[4 * q4 + 2] * sc, oo[4 * q4 + 3] * sc);
                if (MODE == 1) { const uint2 old = *dst; v.x += blo(old.x); v.y += bhi(old.x); v.z += blo(old.y); v.w += bhi(old.y); }
                uint2 w; w.x = cvtpk_s(v.x, v.y); w.y = cvtpk_s(v.z, v.w); *dst = w; }
    }
}
constexpr int DA_K = 0, DA_V = 32768, DA_TAB = 65536;
__device__ __forceinline__ void ph_dsa_attn(const P& p, char* lds) {
    int tid_ = threadIdx.x; asm volatile("" : "+v"(tid_));
    const int tid = tid_, lane = tid & 63, h = __builtin_amdgcn_readfirstlane(tid >> 6), r32 = lane & 31, hi = lane >> 5;
    LAS char* L3 = (LAS char*)lds;
    const bf16_t* cols = WS(bf16_t, W_COLS); const bf16_t* ckvn = WS(bf16_t, W_CKVN);
    const bf16_t* wukb = WS(bf16_t, W_WUKB); const bf16_t* wuvt = WS(bf16_t, W_WUVT);
    { float* tab = (float*)(lds + DA_TAB);
      for (int i = tid; i < 16 * 128; i += 512) tab[i] = p.in[18][bucket(i & 127) * 16 + (i >> 7)] * LOG2E;
      __syncthreads(); }
    const LAS float* tabh = (const LAS float*)(L3 + DA_TAB) + (8 + h) * 128; const float bfar = tabh[127];
    unsigned kd0[2], vd[2]; int skey[2], sch[2];
#pragma unroll
    for (int i = 0; i < 2; ++i) { const int pc = tid + 512 * i; skey[i] = pc >> 4; sch[i] = pc & 15;
        kd0[i] = DA_K + (sch[i] >> 1) * 2048 + skey[i] * 16 + (sch[i] & 1) * 8;   vd[i] = DA_V + ((sch[i] >> 2) * 4 + (skey[i] >> 4)) * 1024 + (skey[i] & 15) * 64 + (sch[i] & 3) * 16; }
    const unsigned kfb = DA_K + hi * 1024 + r32 * 16;
    const unsigned vfb = DA_V + (4 * hi + ((lane & 15) >> 2)) * 64 + ((lane >> 4) & 1) * 32 + (lane & 3) * 8;
    typedef unsigned u32x2_t __attribute__((ext_vector_type(2)));
    for (int it = 0; it < 4; ++it) {
        const int vc = (int)blockIdx.x + it * (int)gridDim.x; if (vc >= 1024) break;
        const int cu = vc % 256, rep = vc / 256, b = 2 * (cu & 7) + (cu >> 7), s16 = (cu >> 3) & 15;
        const int qb = rep == 0 ? s16 : rep == 1 ? 31 - s16 : rep == 2 ? 32 + s16 : 63 - s16;
        const int tq = qb * 32 + r32; const size_t token = (size_t)b * 2048 + tq;
        const bf16_t* kvbase = ckvn + (size_t)b * 2048 * 128;
        bf16x8_t qa[8];
        int wuko = (h * 128 + r32) * 64 + 8 * hi; asm volatile("" : "+v"(wuko)); const bf16_t* wukl = wukb + wuko;
        { bf16x8_t qd[4]; const bf16_t* qp = cols + token * NCOL + C_QD + h * 64 + hi * 8;
#pragma unroll
          for (int k0 = 0; k0 < 4; ++k0) qd[k0] = *(const bf16x8_t*)(qp + 16 * k0);
          bf16x8_t wa[4][4];
#pragma unroll
          for (int cb = 0; cb < 4; ++cb)
#pragma unroll
              for (int k0 = 0; k0 < 4; ++k0) wa[cb][k0] = *(const bf16x8_t*)(wukl + cb * 2048 + 16 * k0);
          __builtin_amdgcn_sched_barrier(0);
#pragma unroll
          for (int cb = 0; cb < 4; ++cb) { f32x16_t X = {};
#pragma unroll
              for (int k0 = 0; k0 < 4; ++k0) X = __builtin_amdgcn_mfma_f32_32x32x16_bf16(wa[cb][k0], qd[k0], X, 0, 0, 0);
#pragma unroll
              for (int s = 0; s < 2; ++s) { const u32x4_t wv = {cvtpk_s(X[8 * s + 0], X[8 * s + 1]), cvtpk_s(X[8 * s + 2], X[8 * s + 3]), cvtpk_s(X[8 * s + 4], X[8 * s + 5]), cvtpk_s(X[8 * s + 6], X[8 * s + 7])};
                  qa[2 * cb + s] = __builtin_bit_cast(bf16x8_t, wv); } } }
        const unsigned long long* mbase = WS(unsigned long long, W_DMASK) + ((size_t)b * 2048 + qb * 32) * 32; const int moff = r32 * 32;
        const int ntile = (qb >> 1) + 1;
        float m_run = 0.f, l_run = 0.f; bool unset = true; f32x16_t o[4] = {{}, {}, {}, {}};
        u32x4_t sreg[2];
#pragma unroll
        for (int i = 0; i < 2; ++i) sreg[i] = *(const u32x4_t*)(kvbase + (size_t)skey[i] * 128 + sch[i] * 8);
#pragma unroll
        for (int i = 0; i < 2; ++i) { *(LAS u32x2_t*)(L3 + kd0[i]) = (u32x2_t){sreg[i][0], sreg[i][1]}; *(LAS u32x2_t*)(L3 + kd0[i] + 1024) = (u32x2_t){sreg[i][2], sreg[i][3]}; *(LAS u32x4_t*)(L3 + vd[i]) = sreg[i]; }
        unsigned long long mw = mbase[moff];
        __syncthreads();
        __builtin_amdgcn_s_waitcnt(0);
        int buf = 0;
        for (int cur = 0; cur < ntile; ++cur) {
            const bool more = cur + 1 < ntile;
            unsigned long long mwn = 0ull;
            if (more) {
#pragma unroll
                for (int i = 0; i < 2; ++i) sreg[i] = *(const u32x4_t*)(kvbase + (size_t)((cur + 1) * 64 + skey[i]) * 128 + sch[i] * 8);
                mwn = mbase[moff + cur + 1]; }
            {
                const unsigned kb_ = kfb + buf * 16384, vb_ = vfb + buf * 16384;
                const int kbase = cur * 64;
                const bool slow = (qb * 32 - (kbase + 63)) < 128;
                unsigned mlo = (unsigned)mw >> (4 * hi), mhi = (unsigned)(mw >> 32) >> (4 * hi);
                f32x16_t p0, p1;
                if (slow) { const int dq = tq - kbase - 4 * hi; asm volatile("" : "+v"(mlo), "+v"(mhi));
#pragma unroll
                    for (int r = 0; r < 16; ++r) { const int c = (r & 3) + 8 * (r >> 2); const int d0_ = dq - c, d1_ = dq - c - 32;
                        const float b0 = tabh[d0_ < 0 ? 0 : (d0_ > 127 ? 127 : d0_)], b1 = tabh[d1_ < 0 ? 0 : (d1_ > 127 ? 127 : d1_)];
                        p0[r] = ((mlo >> c) & 1u) ? b0 - m_run : -INFINITY; p1[r] = ((mhi >> c) & 1u) ? b1 - m_run : -INFINITY; }
                } else { const int vb = (int)__float_as_uint(bfar - m_run); asm volatile("" : "+v"(mlo), "+v"(mhi));
#pragma unroll
                    for (int r = 0; r < 16; ++r) { const int c = (r & 3) + 8 * (r >> 2);
                        const int M0 = __builtin_amdgcn_sbfe((int)mlo, c, 1), M1 = __builtin_amdgcn_sbfe((int)mhi, c, 1);
                        p0[r] = __uint_as_float((unsigned)((M0 & vb) | (~M0 & (int)0xff800000))); p1[r] = __uint_as_float((unsigned)((M1 & vb) | (~M1 & (int)0xff800000))); } }
                u32x4_t kq[3][2];
#define DA_KLD(KC) do { kq[(KC) % 3][0] = *(const LAS u32x4_t*)(L3 + kb_ + (KC) * 2048); kq[(KC) % 3][1] = *(const LAS u32x4_t*)(L3 + kb_ + (KC) * 2048 + 512); } while (0)
                DA_KLD(0); DA_KLD(1);
#pragma unroll
                for (int kc = 0; kc < 8; ++kc) {
                    __builtin_amdgcn_sched_barrier(0);
                    if (kc + 2 < 8) DA_KLD(kc + 2);
                    __builtin_amdgcn_sched_barrier(0);
                    p0 = __builtin_amdgcn_mfma_f32_32x32x16_bf16(__builtin_bit_cast(bf16x8_t, kq[kc % 3][0]), qa[kc], p0, 0, 0, 0);
                    p1 = __builtin_amdgcn_mfma_f32_32x32x16_bf16(__builtin_bit_cast(bf16x8_t, kq[kc % 3][1]), qa[kc], p1, 0, 0, 0); }
#undef DA_KLD
                __builtin_amdgcn_sched_barrier(0);
                float mx = p0[0];
#pragma unroll
                for (int r = 0; r < 16; ++r) { if (r) mx = fmaxf(mx, p0[r]); mx = fmaxf(mx, p1[r]); }
                { const auto rr = __builtin_amdgcn_permlane32_swap(__float_as_uint(mx), __float_as_uint(mx), false, false); mx = fmaxf(__uint_as_float(rr[0]), __uint_as_float(rr[1])); }
                const bool mv = mx > -INFINITY && (unset || mx > 8.f);
                if (__ballot(mv)) {
                    const float sh = mv ? mx : 0.f;
                    m_run += sh; const float alpha = (mv && !unset) ? __builtin_amdgcn_exp2f(-sh) : 1.f; l_run *= alpha; unset = unset && !mv;
#pragma unroll
                    for (int r = 0; r < 16; ++r) { p0[r] -= sh; p1[r] -= sh; }
#pragma unroll
                    for (int cb = 0; cb < 4; ++cb)
#pragma unroll
                        for (int r = 0; r < 16; ++r) o[cb][r] *= alpha; }
                float rs = 0.f;
#pragma unroll
                for (int r = 0; r < 16; ++r) { p0[r] = __builtin_amdgcn_exp2f(p0[r]); p1[r] = __builtin_amdgcn_exp2f(p1[r]); rs += p0[r] + p1[r]; }
                l_run += rs;
#pragma unroll
                for (int ks = 0; ks < 4; ++ks) {
                    __builtin_amdgcn_sched_barrier(0);
                    bf16x8_t pf;
                    { const f32x16_t& pp = (ks < 2) ? p0 : p1; const int s = (ks & 1) * 8;
                      const u32x4_t wv = {cvtpk_s(pp[s + 0], pp[s + 1]), cvtpk_s(pp[s + 2], pp[s + 3]), cvtpk_s(pp[s + 4], pp[s + 5]), cvtpk_s(pp[s + 6], pp[s + 7])};
                      pf = __builtin_bit_cast(bf16x8_t, wv); }
#pragma unroll
                    for (int cb = 0; cb < 4; ++cb) {
                        const s16x4_t lo = lds_tr16(L3 + vb_ + (cb * 4 + ks) * 1024), hh = lds_tr16(L3 + vb_ + (cb * 4 + ks) * 1024 + 512);
                        const bf16x8_t vf = {lo[0], lo[1], lo[2], lo[3], hh[0], hh[1], hh[2], hh[3]};
                        o[cb] = __builtin_amdgcn_mfma_f32_32x32x16_bf16(vf, pf, o[cb], 0, 0, 0); }
                }
            }
            if (more) {
#pragma unroll
                for (int i = 0; i < 2; ++i) { const unsigned ob = (buf ^ 1) * 16384; *(LAS u32x2_t*)(L3 + kd0[i] + ob) = (u32x2_t){sreg[i][0], sreg[i][1]}; *(LAS u32x2_t*)(L3 + kd0[i] + ob + 1024) = (u32x2_t){sreg[i][2], sreg[i][3]}; *(LAS u32x4_t*)(L3 + vd[i] + ob) = sreg[i]; } }
            __syncthreads();
            mw = mwn; buf ^= 1;
        }
        float l_tot; { const auto rr = __builtin_amdgcn_permlane32_swap(__float_as_uint(l_run), __float_as_uint(l_run), false, false); l_tot = __uint_as_float(rr[0]) + __uint_as_float(rr[1]); }
        const float inv = l_tot > 0.f ? 1.f / l_tot : 0.f;
        f32x16_t od[2] = {{}, {}};
        int wuvo = (h * 64 + r32) * 128 + 4 * hi; asm volatile("" : "+v"(wuvo)); const bf16_t* wuvl = wuvt + wuvo;
        u32x2_t wq[4][2][2][2];
#pragma unroll
        for (int cb = 0; cb < 4; ++cb)
#pragma unroll
            for (int s = 0; s < 2; ++s)
#pragma unroll
                for (int db = 0; db < 2; ++db) { const bf16_t* wp = wuvl + db * 4096 + 32 * cb + 16 * s; wq[cb][s][db][0] = *(const u32x2_t*)wp; wq[cb][s][db][1] = *(const u32x2_t*)(wp + 8); }
        __builtin_amdgcn_sched_barrier(0);
#pragma unroll
        for (int cb = 0; cb < 4; ++cb)
#pragma unroll
            for (int s = 0; s < 2; ++s) {
                const u32x4_t wv = {cvtpk_s(o[cb][8 * s + 0] * inv, o[cb][8 * s + 1] * inv), cvtpk_s(o[cb][8 * s + 2] * inv, o[cb][8 * s + 3] * inv),
                                    cvtpk_s(o[cb][8 * s + 4] * inv, o[cb][8 * s + 5] * inv), cvtpk_s(o[cb][8 * s + 6] * inv, o[cb][8 * s + 7] * inv)};
                const bf16x8_t of = __builtin_bit_cast(bf16x8_t, wv);
#pragma unroll
                for (int db = 0; db < 2; ++db) { const u32x4_t wf = {wq[cb][s][db][0][0], wq[cb][s][db][0][1], wq[cb][s][db][1][0], wq[cb][s][db][1][1]};
                    od[db] = __builtin_amdgcn_mfma_f32_32x32x16_bf16(__builtin_bit_cast(bf16x8_t, wf), of, od[db], 0, 0, 0); } }
        bf16_t* op = WS(bf16_t, W_ODSA) + ((size_t)b * 2048 + qb * 32) * 512 + r32 * 512 + h * 64 + 4 * hi;
#pragma unroll
        for (int db = 0; db < 2; ++db)
#pragma unroll
            for (int q4 = 0; q4 < 4; ++q4) { uint2 w; w.x = cvtpk_s(od[db][4 * q4], od[db][4 * q4 + 1]); w.y = cvtpk_s(od[db][4 * q4 + 2], od[db][4 * q4 + 3]); *(uint2*)(op + 32 * db + 8 * q4) = w; }
    }
}
__device__ __forceinline__ int wsum_dpp(int v) {
    v += __builtin_amdgcn_update_dpp(0, v, 0xB1, 0xF, 0xF, false);
    v += __builtin_amdgcn_update_dpp(0, v, 0x4E, 0xF, 0xF, false);
    v += __builtin_amdgcn_update_dpp(0, v, 0x141, 0xF, 0xF, false);
    v += __builtin_amdgcn_update_dpp(0, v, 0x140, 0xF, 0xF, false);
    return __builtin_amdgcn_readlane(v, 0) + __builtin_amdgcn_readlane(v, 16) + __builtin_amdgcn_readlane(v, 32) + __builtin_amdgcn_readlane(v, 48);
}
__device__ __forceinline__ float wminf_dpp(float v) {
    v = fminf(v, __builtin_bit_cast(float, __builtin_amdgcn_update_dpp(0, __builtin_bit_cast(int, v), 0xB1, 0xF, 0xF, false)));
    v = fminf(v, __builtin_bit_cast(float, __builtin_amdgcn_update_dpp(0, __builtin_bit_cast(int, v), 0x4E, 0xF, 0xF, false)));
    v = fminf(v, __builtin_bit_cast(float, __builtin_amdgcn_update_dpp(0, __builtin_bit_cast(int, v), 0x141, 0xF, 0xF, false)));
    v = fminf(v, __builtin_bit_cast(float, __builtin_amdgcn_update_dpp(0, __builtin_bit_cast(int, v), 0x140, 0xF, 0xF, false)));
    const int iv = __builtin_bit_cast(int, v);
    return fminf(fminf(__builtin_bit_cast(float, __builtin_amdgcn_readlane(iv, 0)), __builtin_bit_cast(float, __builtin_amdgcn_readlane(iv, 16))), fminf(__builtin_bit_cast(float, __builtin_amdgcn_readlane(iv, 32)), __builtin_bit_cast(float, __builtin_amdgcn_readlane(iv, 48))));
}
__device__ __forceinline__ float wmaxf_dpp(float v) {
    v = fmaxf(v, __builtin_bit_cast(float, __builtin_amdgcn_update_dpp(0, __builtin_bit_cast(int, v), 0xB1, 0xF, 0xF, false)));
    v = fmaxf(v, __builtin_bit_cast(float, __builtin_amdgcn_update_dpp(0, __builtin_bit_cast(int, v), 0x4E, 0xF, 0xF, false)));
    v = fmaxf(v, __builtin_bit_cast(float, __builtin_amdgcn_update_dpp(0, __builtin_bit_cast(int, v), 0x141, 0xF, 0xF, false)));
    v = fmaxf(v, __builtin_bit_cast(float, __builtin_amdgcn_update_dpp(0, __builtin_bit_cast(int, v), 0x140, 0xF, 0xF, false)));
    const int iv = __builtin_bit_cast(int, v);
    return fmaxf(fmaxf(__builtin_bit_cast(float, __builtin_amdgcn_readlane(iv, 0)), __builtin_bit_cast(float, __builtin_amdgcn_readlane(iv, 16))), fmaxf(__builtin_bit_cast(float, __builtin_amdgcn_readlane(iv, 32)), __builtin_bit_cast(float, __builtin_amdgcn_readlane(iv, 48))));
}
__device__ __forceinline__ unsigned wmaxu_dpp(unsigned x) {
    unsigned v = x; unsigned t;
    t = (unsigned)__builtin_amdgcn_update_dpp(0, (int)v, 0xB1, 0xF, 0xF, false); v = v > t ? v : t;
    t = (unsigned)__builtin_amdgcn_update_dpp(0, (int)v, 0x4E, 0xF, 0xF, false); v = v > t ? v : t;
    t = (unsigned)__builtin_amdgcn_update_dpp(0, (int)v, 0x141, 0xF, 0xF, false); v = v > t ? v : t;
    t = (unsigned)__builtin_amdgcn_update_dpp(0, (int)v, 0x140, 0xF, 0xF, false); v = v > t ? v : t;
    const unsigned a = (unsigned)__builtin_amdgcn_readlane((int)v, 0), b = (unsigned)__builtin_amdgcn_readlane((int)v, 16), c = (unsigned)__builtin_amdgcn_readlane((int)v, 32), d = (unsigned)__builtin_amdgcn_readlane((int)v, 48);
    const unsigned ab = a > b ? a : b, cd = c > d ? c : d; return ab > cd ? ab : cd;
}
__device__ __forceinline__ unsigned wminu_dpp(unsigned x) { return ~wmaxu_dpp(~x); }
__device__ __forceinline__ int wsuffix_dpp(int x) {
    int v = x;
    v += __builtin_amdgcn_update_dpp(0, v, 0x111, 0xF, 0xF, false);
    v += __builtin_amdgcn_update_dpp(0, v, 0x112, 0xF, 0xF, false);
    v += __builtin_amdgcn_update_dpp(0, v, 0x114, 0xF, 0xF, false);
    v += __builtin_amdgcn_update_dpp(0, v, 0x118, 0xF, 0xF, false);
    v += __builtin_amdgcn_update_dpp(0, v, 0x142, 0xA, 0xF, false);
    v += __builtin_amdgcn_update_dpp(0, v, 0x143, 0xC, 0xF, false);
    return __builtin_amdgcn_readlane(v, 63) - v + x;
}
constexpr int DI_SC = 0, DI_K = 131072;
template <int PARTS>
__device__ __forceinline__ void ph_dsa_index(const P& p, char* lds, unsigned long long* dmask) {
    int tid_ = threadIdx.x; asm volatile("" : "+v"(tid_));
    const int tid = tid_, lane = tid & 63, wid = __builtin_amdgcn_readfirstlane(tid >> 6), r32 = lane & 31, hi = lane >> 5, rb2 = wid & 1, par = wid >> 1;
    LAS char* L3 = (LAS char*)lds;
    float* sc = (float*)(lds + DI_SC);
    const bf16_t* cols = WS(bf16_t, W_COLS); const bf16_t* kiln = WS(bf16_t, W_KILN);
    for (int it = 0; it < 8; ++it) {
        const int vc = (int)blockIdx.x + it * (int)gridDim.x; if (vc >= 2048) break;
        const int cu = vc % 256, rep = vc / 256, b = 2 * (cu & 7) + (cu >> 7), s16 = (cu >> 3) & 15;
        const int tb = (rep >> 1) * 32 + ((rep & 1) ? 31 - s16 : s16);
        const int t0 = tb * 16;
        const bf16_t* kbase_p = kiln + (size_t)b * 2048 * 64;
        bf16x8_t qf[2][4]; float wgt[2][16];
#pragma unroll
        for (int rb = 0; rb < 2; ++rb) { const int rowblk = 2 * rb2 + rb;
          const size_t tok = (size_t)b * 2048 + t0 + 4 * rowblk + (r32 >> 3); const bf16_t* qp = cols + tok * NCOL + C_QI + (r32 & 7) * 64 + hi * 8;
#pragma unroll
          for (int d0 = 0; d0 < 4; ++d0) qf[rb][d0] = *(const bf16x8_t*)(qp + 16 * d0);
#pragma unroll
          for (int r = 0; r < 16; ++r) wgt[rb][r] = bf2f(cols[((size_t)b * 2048 + t0 + 4 * rowblk + (r >> 2)) * NCOL + C_WI + (r & 3) + 4 * hi]) * 0.044194173824159216f; }
        const int ntile = ((t0 + 15) >> 6) + 1;
        int klo = r32 * 64 + 8 * hi; asm volatile("" : "+v"(klo));
        const bf16_t* kl = kbase_p + klo;
        bf16x8_t kf[8], kn[8];
        if ((PARTS & 1) && par < ntile) {
#pragma unroll
            for (int q = 0; q < 8; ++q) kf[q] = *(const bf16x8_t*)(kl + (size_t)(par * 64 + 32 * (q >> 2)) * 64 + 16 * (q & 3)); }
        __builtin_amdgcn_s_waitcnt(0);
#pragma unroll 1
        for (int kt = par; (PARTS & 1) && kt < ntile; kt += 4) {
            const bool more = kt + 4 < ntile;
            if (more) {
#pragma unroll
                for (int q = 0; q < 8; ++q) kn[q] = *(const bf16x8_t*)(kl + (size_t)((kt + 4) * 64 + 32 * (q >> 2)) * 64 + 16 * (q & 3)); }
#pragma unroll
            for (int rb = 0; rb < 2; ++rb)
#pragma unroll
            for (int cbk = 0; cbk < 2; ++cbk) {
                f32x16_t C = {};
#pragma unroll
                for (int d0 = 0; d0 < 4; ++d0) C = __builtin_amdgcn_mfma_f32_32x32x16_bf16(qf[rb][d0], kf[4 * cbk + d0], C, 0, 0, 0);
                float part[4];
#pragma unroll
                for (int tl = 0; tl < 4; ++tl) { float a = 0.f;
#pragma unroll
                    for (int hh = 0; hh < 4; ++hh) a += fmaxf(C[4 * tl + hh], 0.f) * wgt[rb][4 * tl + hh];
                    const auto rr = __builtin_amdgcn_permlane32_swap(__float_as_uint(a), __float_as_uint(a), false, false); part[tl] = __uint_as_float(rr[0]) + __uint_as_float(rr[1]); }
                float* dst = sc + (4 * (2 * rb2 + rb)) * 2048 + kt * 64 + 32 * cbk + r32;
                { float* d2 = dst + (hi ? 2 * 2048 : 0); d2[0] = hi ? part[2] : part[0]; d2[2048] = hi ? part[3] : part[1]; }
            }
            if (more) {
#pragma unroll
                for (int q = 0; q < 8; ++q) kf[q] = kn[q]; }
        }
        LDS_BARRIER();
#pragma unroll 1
        for (int tt = 0; (PARTS & 2) && tt < 2; ++tt) {
            const int tl = 2 * wid + tt, t = t0 + tl, n = t + 1, ni = (n + 63) >> 6;
            const float* srow = sc + tl * 2048;
            unsigned long long myword = 0ull;
            if (n <= 256) {
#pragma unroll
                for (int i = 0; i < 4; ++i) { const unsigned long long w = __ballot(64 * i + lane < n); if (lane == i) myword = w; }
            } else {
                float f[32];
#pragma unroll
                for (int i = 0; i < 32; ++i) { const int s = 64 * i + lane; const float v = srow[s]; f[i] = (s < n) ? v : __builtin_nanf(""); }
                float fmn = INFINITY, fmx = -INFINITY;
#pragma unroll
                for (int g = 0; g < 4; ++g) if (ni > 8 * g) {
#pragma unroll
                    for (int i = 0; i < 8; ++i) { fmn = fminf(fmn, f[8 * g + i]); fmx = fmaxf(fmx, f[8 * g + i]); } }
                fmn = wminf_dpp(fmn); fmx = wmaxf_dpp(fmx);
                unsigned* hist = (unsigned*)srow;
                bool done = false;
                if (fmx > fmn) {
                    const float scale = 2047.5f / (fmx - fmn), off = -fmn * scale;
                    asm volatile("s_waitcnt lgkmcnt(0)" ::: "memory");
#pragma unroll
                    for (int q = 0; q < 8; ++q) ((uint4*)hist)[lane + 64 * q] = make_uint4(0u, 0u, 0u, 0u);
                    asm volatile("s_waitcnt lgkmcnt(0)" ::: "memory");
                    unsigned bqp[16];
#pragma unroll
                    for (int g = 0; g < 4; ++g) if (ni > 8 * g) {
#pragma unroll
                        for (int i = 0; i < 8; i += 2) { const int b0_ = (int)fmaxf(fmaf(f[8 * g + i], scale, off), 0.f), b1_ = (int)fmaxf(fmaf(f[8 * g + i + 1], scale, off), 0.f);
                            atomicAdd(hist + b0_, 1u); atomicAdd(hist + b1_, 1u); bqp[(8 * g + i) >> 1] = (unsigned)b0_ | ((unsigned)b1_ << 16); } }
                    asm volatile("s_waitcnt lgkmcnt(0)" ::: "memory");
                    const int ndump = 512 * ((ni + 7) >> 3) - n;
                    int sl = 0; { int ln = lane; asm volatile("" : "+v"(ln));
#pragma unroll
                    for (int q = 0; q < 8; ++q) { const uint4 h4 = ((const uint4*)hist)[8 * ln + ((q + ln) & 7)]; sl += (int)((h4.x + h4.y) + (h4.z + h4.w)); } }
                    if (lane == 0) sl -= ndump;
                    const int incl = wsuffix_dpp(sl);
                    const int excl = incl - sl;
                    const unsigned long long crs = __ballot(excl < 256 && incl >= 256);
                    const int Ls = __builtin_ctzll(crs); const int chi = __builtin_amdgcn_readlane(excl, Ls);
                    int c2 = (lane < 32) ? (int)hist[32 * Ls + lane] : 0; if (Ls == 0 && lane == 0) c2 -= ndump;
                    const int incl2 = wsuffix_dpp(c2);
                    const int excl2 = incl2 - c2;
                    const unsigned long long crs2 = __ballot(lane < 32 && chi + excl2 < 256 && chi + incl2 >= 256);
                    const int js = __builtin_ctzll(crs2); const int bstar = 32 * Ls + js;
                    const int cab = chi + __builtin_amdgcn_readlane(excl2, js), m = __builtin_amdgcn_readlane(c2, js), need = 256 - cab;
                    if (crs != 0ull && crs2 != 0ull && m <= 64 && need >= 1 && need <= m) {
                        unsigned* cl = (unsigned*)(lds + 147456 + wid * 256);
                        int base = 0;
#pragma unroll
                        for (int g = 0; g < 4; ++g) if (ni > 8 * g) {
#pragma unroll
                            for (int i = 0; i < 8; ++i) { const int bq = (int)((i & 1) ? bqp[(8 * g + i) >> 1] >> 16 : bqp[(8 * g + i) >> 1] & 0xffffu); const bool inb = (bq == bstar) && (64 * (8 * g + i) + lane < n); const unsigned long long bal = __ballot(inb);
                                if (bal) { const int slot = base + __builtin_amdgcn_mbcnt_hi((unsigned)(bal >> 32), __builtin_amdgcn_mbcnt_lo((unsigned)bal, 0u)); if (inb) cl[slot & 63] = ukey(f[8 * g + i]); base += __builtin_popcountll(bal); } } }
                        asm volatile("s_waitcnt lgkmcnt(0)" ::: "memory");
                        const bool vld = lane < m; const unsigned mine = vld ? cl[lane] : 0u;
                        const unsigned kmx = wmaxu_dpp(mine), kmn = wminu_dpp(vld ? mine : 0xffffffffu);
                        const unsigned dif = kmx ^ kmn;
                        const int top = dif ? 31 - __builtin_clz(dif) : -1;
                        unsigned T = top >= 31 ? 0u : (kmx & ~((2u << (top < 0 ? 0 : top)) - 1u));
                        if (top < 0) T = kmx;
#pragma unroll 1
                        for (int bit = top; bit >= 0; --bit) { const unsigned c = T | (1u << bit); if (__builtin_popcountll(__ballot(vld && mine >= c)) >= need) T = c; }
                        int rem = need - __builtin_popcountll(__ballot(vld && mine > T));
                        asm volatile("s_waitcnt lgkmcnt(0)" ::: "memory");
                        if (base == m) {
#pragma unroll
                            for (int g = 0; g < 4; ++g) if (ni > 8 * g) {
#pragma unroll
                                for (int i = 0; i < 8; ++i) { const int bq = (int)((i & 1) ? bqp[(8 * g + i) >> 1] >> 16 : bqp[(8 * g + i) >> 1] & 0xffffu); unsigned long long w = __ballot(bq > bstar);
                                    const bool inb = (bq == bstar) && (64 * (8 * g + i) + lane < n); const unsigned long long inq = __ballot(inb);
                                    if (inq) { const unsigned kv = ukey(f[8 * g + i]); w |= __ballot(inb && kv > T); const unsigned long long eqb = __ballot(inb && kv == T);
                                        if (eqb) { const int rk = __builtin_amdgcn_mbcnt_hi((unsigned)(eqb >> 32), __builtin_amdgcn_mbcnt_lo((unsigned)eqb, 0u)); w |= __ballot(inb && kv == T && rk < rem); rem -= __builtin_popcountll(eqb); rem = rem < 0 ? 0 : rem; } }
                                    if (lane == 8 * g + i) myword = w; } }
                            done = true;
                        }
                    }
                }
                if (!done) {
                    unsigned k[32];
    #pragma unroll
                    for (int i = 0; i < 32; ++i) { const int s = 64 * i + lane; k[i] = (s < n) ? ukey(f[i]) : 0u; }
    #define DI_COUNT(dst, EXPR) do { int c_ = 0; \
                        _Pragma("unroll") for (int g_ = 0; g_ < 4; ++g_) if (ni > 8 * g_) { _Pragma("unroll") for (int i_ = 0; i_ < 8; ++i_) { const unsigned kv_ = k[8 * g_ + i_]; c_ += (EXPR) ? 1 : 0; } } \
                        dst = wsum_dpp(c_); } while (0)
                    unsigned prefix = 0u; int cge = 0;
    #pragma unroll 1
                    for (int bit = 31; bit >= 16; --bit) { const unsigned cand = prefix | (1u << bit); int tot; DI_COUNT(tot, kv_ >= cand); if (tot >= 256) { prefix = cand; cge = tot; } }
                    int cab = 0;
                    if (prefix < 0xffff0000u) { const unsigned hb = prefix + 0x10000u; DI_COUNT(cab, kv_ >= hb); }
                    const int m = cge - cab, need = 256 - cab;
                    unsigned T; int cgt;
                    if (m <= 64) {
                        unsigned* cl = (unsigned*)(lds + 147456 + wid * 256);
                        int base = 0;
    #pragma unroll
                        for (int g = 0; g < 4; ++g) if (ni > 8 * g) {
    #pragma unroll
                            for (int i = 0; i < 8; ++i) { const unsigned kv = k[8 * g + i]; const bool inb = (kv - prefix) < 0x10000u; const unsigned long long bal = __ballot(inb);
                                if (bal) { const int slot = base + __builtin_amdgcn_mbcnt_hi((unsigned)(bal >> 32), __builtin_amdgcn_mbcnt_lo((unsigned)bal, 0u)); if (inb) cl[slot] = kv & 0xffffu; base += __builtin_popcountll(bal); } } }
                        __builtin_amdgcn_fence(__ATOMIC_RELEASE, "wavefront"); asm volatile("s_waitcnt lgkmcnt(0)" ::: "memory");
                        const bool vld = lane < m; const unsigned mine = vld ? cl[lane] : 0u;
                        unsigned pl = 0u;
    #pragma unroll 1
                        for (int bit = 15; bit >= 0; --bit) { const unsigned c = pl | (1u << bit); if (__builtin_popcountll(__ballot(vld && mine >= c)) >= need) pl = c; }
                        T = prefix | pl; cgt = cab + __builtin_popcountll(__ballot(vld && mine > pl));
                        asm volatile("s_waitcnt lgkmcnt(0)" ::: "memory");
                    } else {
    #pragma unroll 1
                        for (int bit = 15; bit >= 0; --bit) { const unsigned cand = prefix | (1u << bit); int tot; DI_COUNT(tot, kv_ >= cand); if (tot >= 256) prefix = cand; }
                        T = prefix; DI_COUNT(cgt, kv_ > T);
                    }
                    int rem = 256 - cgt;
    #pragma unroll
                    for (int g = 0; g < 4; ++g) if (ni > 8 * g) {
    #pragma unroll
                        for (int i = 0; i < 8; ++i) { const unsigned kv = k[8 * g + i]; unsigned long long w = __ballot(kv > T); const unsigned long long eqb = __ballot(kv == T);
                            if (eqb) { const int rk = __builtin_amdgcn_mbcnt_hi((unsigned)(eqb >> 32), __builtin_amdgcn_mbcnt_lo((unsigned)eqb, 0u)); w |= __ballot(kv == T && rk < rem); rem -= __builtin_popcountll(eqb); rem = rem < 0 ? 0 : rem; }
                            if (lane == 8 * g + i) myword = w; } }
#undef DI_COUNT
                }
            }
            if (lane < 32) dmask[((size_t)b * 2048 + t) * 32 + lane] = myword;
        }
        LDS_BARRIER();
    }
}
constexpr int LR_HS = 0, LR_ROW = 1028, LR_LGT = 135168;
typedef float f32x16r_t __attribute__((ext_vector_type(16)));
template <int PARTS>
__device__ __forceinline__ void ph_lnroute_fast(const P& p, char* lds, bf16_t* xout, unsigned char* h2out, int* cntb, int* tope, float* topw, int* pos, int* bbase) {
    int tid_ = threadIdx.x; asm volatile("" : "+v"(tid_));
    const int tid = tid_, lane = tid & 63, wid = tid >> 6, r32 = lane & 31, hi = lane >> 5;
    float* hs = (float*)(lds + LR_HS); float* lgt = (float*)(lds + LR_LGT);
    const float* ada = WS(float, W_ADA);
    int* lcnt = (int*)(lds + LR_LGT + 4096);
    if (tid < NCHUNK * 32) lcnt[tid] = 0;
    float4 gn1[4], bs1[4];
#pragma unroll
    for (int j = 0; j < 4; ++j) { gn1[j] = *(const float4*)(p.in[20] + j * 256 + lane * 4); bs1[j] = *(const float4*)(p.in[21] + j * 256 + lane * 4); }
    __syncthreads();
    for (int blk = blockIdx.x; blk < T_ / 32; blk += gridDim.x) {
        float4 sc2[4], sh2[4];
        { const float* ab_ = ada + ((blk * 32) >> 11) * 6144;
#pragma unroll
          for (int j = 0; j < 4; ++j) { sc2[j] = *(const float4*)(ab_ + 4096 + j * 256 + lane * 4); sh2[j] = *(const float4*)(ab_ + 3072 + j * 256 + lane * 4); } }
        float4 z[4][4];
#pragma unroll
        for (int tt = 0; tt < 4; ++tt) { const size_t u_ = (size_t)(blk * 32 + 4 * wid + tt); const float* xrow = p.in[0] + u_ * 1024; const bf16_t* yrow = WS(bf16_t, W_YB) + u_ * 1024; const float* g1 = ada + (int)(u_ >> 11) * 6144 + 2048;
#pragma unroll
            for (int j = 0; j < 4; ++j) { const int c = j * 256 + lane * 4; const float4 xv = ldnt4(xrow + c), gv = *(const float4*)(g1 + c); const uint2 yv = ldnt2(yrow + c);
                z[tt][j] = make_float4(ALPHA * xv.x + (1.f + gv.x) * blo(yv.x), ALPHA * xv.y + (1.f + gv.y) * bhi(yv.x), ALPHA * xv.z + (1.f + gv.z) * blo(yv.y), ALPHA * xv.w + (1.f + gv.w) * bhi(yv.y)); } }
#pragma unroll
        for (int tt = 0; tt < 4; ++tt) {
            const int tl = 4 * wid + tt, u = blk * 32 + tl, b = u >> 11;
            float s = 0.f;
#pragma unroll
            for (int j = 0; j < 4; ++j) s += (z[tt][j].x + z[tt][j].y) + (z[tt][j].z + z[tt][j].w);
            const float mu = wsum(s) * (1.f / 1024.f); float q = 0.f;
#pragma unroll
            for (int j = 0; j < 4; ++j) { z[tt][j].x -= mu; z[tt][j].y -= mu; z[tt][j].z -= mu; z[tt][j].w -= mu; q += (z[tt][j].x * z[tt][j].x + z[tt][j].y * z[tt][j].y) + (z[tt][j].z * z[tt][j].z + z[tt][j].w * z[tt][j].w); }
            const float rs = rsqrtf(wsum(q) * (1.f / 1024.f) + 1e-5f);
#pragma unroll
            for (int j = 0; j < 4; ++j) { const int c = j * 256 + lane * 4;
                const float4 gn = gn1[j], bs = bs1[j];
                const float4 x1 = make_float4(z[tt][j].x * rs * gn.x + bs.x, z[tt][j].y * rs * gn.y + bs.y, z[tt][j].z * rs * gn.z + bs.z, z[tt][j].w * rs * gn.w + bs.w);
                { typedef unsigned u2n_ __attribute__((ext_vector_type(2))); const u2n_ xo = {pk2(x1.x, x1.y), pk2(x1.z, x1.w)}; __builtin_nontemporal_store(xo, (u2n_*)(xout + (size_t)u * 1024 + c)); }
                const float4 sc = sc2[j], sh = sh2[j];
                const float4 h = make_float4(x1.x * (1.f + sc.x) + sh.x, x1.y * (1.f + sc.y) + sh.y, x1.z * (1.f + sc.z) + sh.z, x1.w * (1.f + sc.w) + sh.w);
                *(unsigned*)(h2out + (size_t)u * 1024 + c) = pk4_fp8(h.x, h.y, h.z, h.w);
                *(float4*)(hs + tl * LR_ROW + c) = h; }
        }
        LDS_BARRIER();
        if (!(PARTS & 2)) continue;
        f32x16r_t C = {};
        { const float* ap = hs + r32 * LR_ROW + 128 * wid; const float* wp = p.in[22] + (size_t)(128 * wid + hi) * 32 + r32;
#pragma unroll 4
          for (int k4 = 0; k4 < 32; ++k4) { const float4 av = *(const float4*)(ap + 4 * k4);
              const float b0 = wp[(4 * k4) * 32], b1 = wp[(4 * k4 + 2) * 32];
              C = __builtin_amdgcn_mfma_f32_32x32x2f32(hi ? av.y : av.x, b0, C, 0, 0, 0);
              C = __builtin_amdgcn_mfma_f32_32x32x2f32(hi ? av.w : av.z, b1, C, 0, 0, 0); } }
        LDS_BARRIER();
        { float* part = hs + wid * 1024;
#pragma unroll
          for (int r = 0; r < 16; ++r) part[((r & 3) + 8 * (r >> 2) + 4 * hi) * 32 + r32] = C[r]; }
        LDS_BARRIER();
#pragma unroll
        for (int i2 = 0; i2 < 2; ++i2) { const int o = tid + 512 * i2; float a = p.in[23][o & 31];
#pragma unroll
            for (int w = 0; w < 8; ++w) a += hs[w * 1024 + o];
            lgt[o] = a; }
        LDS_BARRIER();
        if ((PARTS & 4) && tid < 32) { const int u = blk * 32 + tid; float lv[32];
#pragma unroll
            for (int q = 0; q < 8; ++q) { const float4 v = *(const float4*)(lgt + tid * 32 + 4 * q); lv[4 * q] = v.x; lv[4 * q + 1] = v.y; lv[4 * q + 2] = v.z; lv[4 * q + 3] = v.w; }
            int te[4]; float tv[4]; unsigned used = 0u;
#pragma unroll
            for (int k = 0; k < 4; ++k) { int best = 0; float bv = -INFINITY;
#pragma unroll
                for (int e = 0; e < 32; ++e) { const bool take = !((used >> e) & 1u) && (lv[e] > bv); best = take ? e : best; bv = take ? lv[e] : bv; }
                used |= 1u << best; te[k] = best; tv[k] = bv; }
            const float m = tv[0]; float ex[4], sm = 0.f;
#pragma unroll
            for (int k = 0; k < 4; ++k) { ex[k] = expf(tv[k] - m); sm += ex[k]; }
            const int ch = u / CHT;
#pragma unroll
            for (int k = 0; k < 4; ++k) { tope[u * 4 + k] = te[k]; topw[u * 4 + k] = ex[k] / sm;
                pos[u * 4 + k] = atomicAdd(lcnt + ch * 32 + te[k], 1); } }
        LDS_BARRIER();
    }
    if ((PARTS & 4) && tid < NCHUNK * 32) { const int c = lcnt[tid]; bbase[blockIdx.x * (NCHUNK * 32) + tid] = c ? atomicAdd(cntb + tid, c) : 0; }
}
constexpr int CA_K = 0, CA_V = 16384, CA_TAB = 32768, CA_PS = 40960, CA_IMP = 73728;
__device__ __forceinline__ void ph_nsa_cmp(const P& p, char* lds, bf16_t* onsa) {
    int tid_ = threadIdx.x; asm volatile("" : "+v"(tid_));
    const int tid = tid_, lane = tid & 63, wid = __builtin_amdgcn_readfirstlane(tid >> 6), r32 = lane & 31, hi = lane >> 5, hr = r32 & 3;
    LAS char* L3 = (LAS char*)lds;
    const bf16_t* cols = WS(bf16_t, W_COLS);
    float* Ps = (float*)(lds + CA_PS); float* impS = (float*)(lds + CA_IMP);
    { float* tab = (float*)(lds + CA_TAB);
      for (int i = tid; i < 16 * 128; i += 512) tab[i] = p.in[18][bucket(i & 127) * 16 + (i >> 7)] * LOG2E;
      __syncthreads(); }
    const unsigned kfb = CA_K + hi * 2048 + r32 * 16;
    const unsigned vfb = CA_V + (4 * hi + ((lane & 15) >> 2)) * 64 + ((lane >> 4) & 1) * 32 + (lane & 3) * 8;
    for (int vc = blockIdx.x; vc < 1024; vc += gridDim.x) {
        const int bg = vc >> 5, qb = ((vc & 31) + 16 * (vc >> 8)) & 31, b = bg >> 1, g = bg & 1, h = g * 4 + hr;
        const int tloc = 8 * wid + (r32 >> 2), tq = qb * 64 + tloc; const size_t token = (size_t)b * 2048 + tq;
        { const int key = tid >> 2, qtr = tid & 3;
          const float* ksrc = WS(float, W_KC) + ((size_t)(b * NC + key) * 2 + g) * 64 + qtr * 16; const float* vsrc = WS(float, W_VC) + ((size_t)(b * NC + key) * 2 + g) * 64 + qtr * 16;
          float4 kv[4], vv[4];
#pragma unroll
          for (int i = 0; i < 4; ++i) { kv[i] = key < NC ? ((const float4*)ksrc)[i] : make_float4(0.f, 0.f, 0.f, 0.f); vv[i] = key < NC ? ((const float4*)vsrc)[i] : make_float4(0.f, 0.f, 0.f, 0.f); }
#pragma unroll
          for (int c2 = 0; c2 < 2; ++c2) { const int ch = qtr * 2 + c2;
              const u32x4_t kw = {pk2(kv[2 * c2].x, kv[2 * c2].y), pk2(kv[2 * c2].z, kv[2 * c2].w), pk2(kv[2 * c2 + 1].x, kv[2 * c2 + 1].y), pk2(kv[2 * c2 + 1].z, kv[2 * c2 + 1].w)};
              const u32x4_t vw = {pk2(vv[2 * c2].x, vv[2 * c2].y), pk2(vv[2 * c2].z, vv[2 * c2].w), pk2(vv[2 * c2 + 1].x, vv[2 * c2 + 1].y), pk2(vv[2 * c2 + 1].z, vv[2 * c2 + 1].w)};
              *(LAS u32x4_t*)(L3 + CA_K + ch * 2048 + key * 16) = kw;
              *(LAS u32x4_t*)(L3 + CA_V + ((ch >> 2) * 8 + (key >> 4)) * 1024 + (key & 15) * 64 + (ch & 3) * 16) = vw; } }
        bf16x8_t qf[4];
        { const bf16_t* qp = cols + token * NCOL + C_QN + h * 64 + hi * 8;
#pragma unroll
          for (int d0 = 0; d0 < 4; ++d0) qf[d0] = *(const bf16x8_t*)(qp + 16 * d0); }
        const float gate = 1.f / (1.f + __expf(-bf2f(cols[token * NCOL + C_GATE + h * 3 + 0])));
        __syncthreads();
        __builtin_amdgcn_s_waitcnt(0);
        const LAS float* tabh = (const LAS float*)(L3 + CA_TAB) + h * 128;
        f32x16_t S[4] = {{}, {}, {}, {}};
#pragma unroll
        for (int kb = 0; kb < 4; ++kb)
#pragma unroll
            for (int d0 = 0; d0 < 4; ++d0) { const bf16x8_t kf = *(const LAS bf16x8_t*)(L3 + kfb + d0 * 4096 + kb * 512); S[kb] = __builtin_amdgcn_mfma_f32_32x32x16_bf16(kf, qf[d0], S[kb], 0, 0, 0); }
        float mx = -INFINITY;
#pragma unroll
        for (int kb = 0; kb < 4; ++kb) { float bb[16];
#pragma unroll
            for (int r = 0; r < 16; ++r) { const int c = 32 * kb + (r & 3) + 8 * (r >> 2) + 4 * hi; const int dist = tq - 16 * c - 31; bb[r] = tabh[dist < 0 ? 0 : (dist > 127 ? 127 : dist)]; }
            asm volatile("" : "+v"(bb[0]), "+v"(bb[1]), "+v"(bb[2]), "+v"(bb[3]), "+v"(bb[4]), "+v"(bb[5]), "+v"(bb[6]), "+v"(bb[7]), "+v"(bb[8]), "+v"(bb[9]), "+v"(bb[10]), "+v"(bb[11]), "+v"(bb[12]), "+v"(bb[13]), "+v"(bb[14]), "+v"(bb[15]));
#pragma unroll
            for (int r = 0; r < 16; ++r) { const int c = 32 * kb + (r & 3) + 8 * (r >> 2) + 4 * hi; const int dist = tq - 16 * c - 31;
                S[kb][r] = dist >= 0 ? S[kb][r] + bb[r] : -INFINITY; mx = fmaxf(mx, S[kb][r]); } }
        { const auto rr = __builtin_amdgcn_permlane32_swap(__float_as_uint(mx), __float_as_uint(mx), false, false); mx = fmaxf(__uint_as_float(rr[0]), __uint_as_float(rr[1])); }
        const float msafe = mx > -INFINITY ? mx : 0.f;
        float sum = 0.f;
#pragma unroll
        for (int kb = 0; kb < 4; ++kb)
#pragma unroll
            for (int r = 0; r < 16; ++r) { S[kb][r] = __builtin_amdgcn_exp2f(S[kb][r] - msafe); sum += S[kb][r]; }
        { const auto rr = __builtin_amdgcn_permlane32_swap(__float_as_uint(sum), __float_as_uint(sum), false, false); sum = __uint_as_float(rr[0]) + __uint_as_float(rr[1]); }
        const float inv = sum > 0.f ? 1.f / sum : 0.f;
#pragma unroll
        for (int kb = 0; kb < 4; ++kb)
#pragma unroll
            for (int r = 0; r < 16; ++r) S[kb][r] *= inv;
        if (qb >= 16) {
            const int pwo = hr == 0 ? 0 : (81920 - CA_PS) / 4;
#pragma unroll
            for (int kb = 0; kb < 4; ++kb)
#pragma unroll
                for (int r = 0; r < 16; ++r) { float v = S[kb][r]; v += __builtin_bit_cast(float, __builtin_amdgcn_update_dpp(0, __builtin_bit_cast(int, v), 0xB1, 0xF, 0xF, false)); v += __builtin_bit_cast(float, __builtin_amdgcn_update_dpp(0, __builtin_bit_cast(int, v), 0x4E, 0xF, 0xF, false));
                    Ps[pwo + tloc * 128 + 32 * kb + (r & 3) + 8 * (r >> 2) + 4 * hi] = v; }
        }
        f32x16_t o0 = {}, o1 = {};
#pragma unroll
        for (int kg = 0; kg < 8; ++kg) {
            const int kb = kg >> 1, s = (kg & 1) * 8;
            const u32x4_t wv = {cvtpk_s(S[kb][s + 0], S[kb][s + 1]), cvtpk_s(S[kb][s + 2], S[kb][s + 3]), cvtpk_s(S[kb][s + 4], S[kb][s + 5]), cvtpk_s(S[kb][s + 6], S[kb][s + 7])};
            const bf16x8_t pf = __builtin_bit_cast(bf16x8_t, wv);
#pragma unroll
            for (int db = 0; db < 2; ++db) { const s16x4_t lo = lds_tr16(L3 + vfb + (db * 8 + kg) * 1024), hh = lds_tr16(L3 + vfb + (db * 8 + kg) * 1024 + 512);
                const bf16x8_t vf = {lo[0], lo[1], lo[2], lo[3], hh[0], hh[1], hh[2], hh[3]};
                if (db == 0) o0 = __builtin_amdgcn_mfma_f32_32x32x16_bf16(vf, pf, o0, 0, 0, 0); else o1 = __builtin_amdgcn_mfma_f32_32x32x16_bf16(vf, pf, o1, 0, 0, 0); } }
        { bf16_t* op = onsa + token * 512 + h * 64 + 4 * hi;
#pragma unroll
          for (int db = 0; db < 2; ++db)
#pragma unroll
              for (int q4 = 0; q4 < 4; ++q4) { const f32x16_t& oo = db ? o1 : o0; uint2* dst = (uint2*)(op + 32 * db + 8 * q4); const uint2 old = *dst;
                  uint2 w; w.x = cvtpk_s(blo(old.x) + gate * oo[4 * q4], bhi(old.x) + gate * oo[4 * q4 + 1]); w.y = cvtpk_s(blo(old.y) + gate * oo[4 * q4 + 2], bhi(old.y) + gate * oo[4 * q4 + 3]); *dst = w; } }
        if (qb < 16) {
            if (hr == 0 && hi == 0) WS(unsigned, W_SELM)[token * 2 + g] = (2u << qb) - 1u;
            LDS_BARRIER();
        } else {
            LDS_BARRIER();
#pragma unroll
            for (int i4 = 0; i4 < 4; ++i4) { const int idx = i4 * 512 + tid, tk = idx >> 5, j = idx & 31; const float* pp = Ps + tk * 128 + 4 * j;
                impS[idx] = (j > 0 ? pp[-1] : 0.f) + 2.f * (pp[0] + pp[1] + pp[2]) + pp[3]; }
            LDS_BARRIER();
#pragma unroll
            for (int i4 = 0; i4 < 4; ++i4) { const int idx = i4 * 512 + tid, tk = idx >> 5, j = idx & 31; bool sel;
                if (j == 0 || j == qb || j == qb - 1) sel = true;
                else if (j > qb) sel = false;
                else { const float mi = impS[idx]; int rank = 0; const float* ip = impS + tk * 32;
                    for (int jj = 1; jj <= qb - 2; ++jj) { const float o = ip[jj]; rank += (o > mi) || (o == mi && jj < j); }
                    sel = rank < 13; }
                const unsigned long long bal = __ballot(sel);
                if (j == 0) WS(unsigned, W_SELM)[((size_t)b * 2048 + qb * 64 + tk) * 2 + g] = (unsigned)(bal >> (32 * hi)); }
            LDS_BARRIER();
        }
    }
}
struct OneUnit { bool has; int pm;
    __device__ __forceinline__ bool next(int i, pg8::Unit& u) const { if (i != 0 || !has) return false; u.pm = pm; u.pn = 0; return true; }
    __device__ __forceinline__ void a_ready(const pg8::Unit&) const {}
    __device__ __forceinline__ void done(const pg8::Unit&) const {} };
struct EpiGelu { static constexpr bool PERM = true; static constexpr int NSTORE = 16;
    bf16_t* O; const float* bias;
    __device__ __forceinline__ void operator()(const pg8::f32x4 (&acc)[2][2][4][2], const pg8::Unit& u, int wr, int wc, int fr, int fq) const {
        const int row0 = u.pm * 256 + wr * 64 + fr, col0 = wc * 32 + 8 * fq;
#pragma unroll
        for (int ai = 0; ai < 2; ++ai)
#pragma unroll
            for (int m = 0; m < 4; ++m) { bf16_t* rowp = O + (size_t)(row0 + ai * 128 + m * 16) * 256 + col0;
#pragma unroll
                for (int bj = 0; bj < 2; ++bj) { float o[8];
#pragma unroll
                    for (int n = 0; n < 2; ++n)
#pragma unroll
                        for (int j = 0; j < 4; ++j) { const float x = acc[ai][bj][m][n][j] + bias[col0 + bj * 128 + 4 * n + j];
                            const float y = 0.7978845608028654f * (x + 0.044715f * x * x * x); const float e2 = __expf(2.f * y); const float th = 1.f - 2.f * __builtin_amdgcn_rcpf(e2 + 1.f);
                            o[n * 4 + j] = 0.5f * x * (1.f + th); }
                    pg8::u32x4 w; w.x = pg8::cvt_pk_bf16(o[0], o[1]); w.y = pg8::cvt_pk_bf16(o[2], o[3]); w.z = pg8::cvt_pk_bf16(o[4], o[5]); w.w = pg8::cvt_pk_bf16(o[6], o[7]);
                    *(pg8::u32x4*)(rowp + bj * 128) = w; } }
    }
};
__device__ __forceinline__ void ph_compress(const P& p, char* lds) {
    const bool has = blockIdx.x < 32; const int kv = blockIdx.x >> 4, pm = blockIdx.x & 15;
    if (!has) return;
    { pg8::Gemm g{WS(bf16_t, W_KCVB) + (size_t)kv * (16 * 2 * 2048 * 64), WS(bf16_t, kv ? W_W1VB : W_W1KB), 2048};
      OneUnit S{true, pm}; EpiGelu E{WS(bf16_t, W_H1B) + (size_t)kv * 4096 * 256, WS(float, W_BIAS1) + kv * 256};
      pg8::RowsDense AM{2048u};
      pg8::gemm_phase<EpiGelu, OneUnit, pg8::RowsDense, true>((PG8_LAS unsigned char*)lds, g, S, E, AM); }
    asm volatile("s_waitcnt vmcnt(0)" ::: "memory"); __threadfence_block(); __syncthreads();
    int tid_ = threadIdx.x; asm volatile("" : "+v"(tid_));
    const int lane = tid_ & 63, wid = tid_ >> 6, r32 = lane & 31, hi = lane >> 5;
    const bf16_t* hrow = WS(bf16_t, W_H1B) + ((size_t)kv * 4096 + pm * 256 + 32 * wid + r32) * 256 + 8 * hi;
    const bf16_t* w2t = WS(bf16_t, W_W2T) + (size_t)kv * 64 * 256 + (size_t)r32 * 256 + 8 * hi;
    f32x16_t c0 = {}, c1 = {};
#pragma unroll 4
    for (int k0 = 0; k0 < 16; ++k0) { const bf16x8_t a = *(const bf16x8_t*)(hrow + 16 * k0); const bf16x8_t b0 = *(const bf16x8_t*)(w2t + 16 * k0), b1 = *(const bf16x8_t*)(w2t + 32 * 256 + 16 * k0);
        c0 = __builtin_amdgcn_mfma_f32_32x32x16_bf16(a, b0, c0, 0, 0, 0); c1 = __builtin_amdgcn_mfma_f32_32x32x16_bf16(a, b1, c1, 0, 0, 0); }
    float* dstb = WS(float, kv ? W_VC : W_KC);
#pragma unroll
    for (int r = 0; r < 16; ++r) { const int m = pm * 256 + 32 * wid + (r & 3) + 8 * (r >> 2) + 4 * hi, bg = m >> 7, c = m & 127;
        if (c < NC) { float* d = dstb + ((size_t)((bg >> 1) * NC + c) * 2 + (bg & 1)) * 64 + r32; d[0] = c0[r]; d[32] = c1[r]; } }
}

struct WcPiece { const float* src; unsigned char* dst; };
__device__ __forceinline__ WcPiece wc_piece(const P& p, int it, int tid) {
    const int mat = it >> 6, r = it & 63, e = mat / 3, w = mat % 3, kb = r & 15, nq = r >> 4;
    const int k0 = 64 * kb, n = 256 * nq + (tid >> 1), hf = tid & 1;
    WcPiece o;
    o.src = p.in[w == 0 ? 24 : (w == 1 ? 26 : 28)] + (size_t)e * 1048576 + (size_t)(k0 + (tid >> 6)) * 1024 + 256 * nq + (tid & 63) * 4;
    const int row = w == 2 ? ((n & ~255) + 128 * ((n >> 3) & 1) + 32 * ((n >> 6) & 3) + 8 * ((n >> 4) & 3) + (n & 7)) : ((n >> 7) * 256 + w * 128 + (n & 127));
    o.dst = (w == 2 ? WS(unsigned char, W_WDN) + (size_t)e * 1024 * 1024 : WS(unsigned char, W_WGU) + (size_t)e * 2048 * 1024) + (size_t)row * 1024 + k0 + 32 * hf;
    return o;
}
#define WC_LOAD(WV, IT) do { const WcPiece q_ = wc_piece(p, (IT), tid); _Pragma("unroll") for (int i_ = 0; i_ < 8; ++i_) { typedef float f4n_ __attribute__((ext_vector_type(4))); const f4n_ t_ = __builtin_nontemporal_load((const f4n_*)(q_.src + (size_t)i_ * 8192)); WV[i_] = make_float4(t_[0], t_[1], t_[2], t_[3]); } } while (0)
#define WC_FINISH(WV, IT) do { const WcPiece q_ = wc_piece(p, (IT), tid); \
        _Pragma("unroll") for (int i_ = 0; i_ < 8; ++i_) { float* d4_ = scr + (8 * i_ + (tid >> 6)) * 257 + (tid & 63) * 4; d4_[0] = WV[i_].x * WSCALE; d4_[1] = WV[i_].y * WSCALE; d4_[2] = WV[i_].z * WSCALE; d4_[3] = WV[i_].w * WSCALE; } \
        asm volatile("s_waitcnt lgkmcnt(0)\n\ts_barrier" ::: "memory"); \
        const float* s_ = scr + (32 * (tid & 1)) * 257 + (tid >> 1); uint4 o0_, o1_; \
        o0_.x = pk4_fp8(s_[0 * 257], s_[1 * 257], s_[2 * 257], s_[3 * 257]);     o0_.y = pk4_fp8(s_[4 * 257], s_[5 * 257], s_[6 * 257], s_[7 * 257]); \
        o0_.z = pk4_fp8(s_[8 * 257], s_[9 * 257], s_[10 * 257], s_[11 * 257]);   o0_.w = pk4_fp8(s_[12 * 257], s_[13 * 257], s_[14 * 257], s_[15 * 257]); \
        o1_.x = pk4_fp8(s_[16 * 257], s_[17 * 257], s_[18 * 257], s_[19 * 257]); o1_.y = pk4_fp8(s_[20 * 257], s_[21 * 257], s_[22 * 257], s_[23 * 257]); \
        o1_.z = pk4_fp8(s_[24 * 257], s_[25 * 257], s_[26 * 257], s_[27 * 257]); o1_.w = pk4_fp8(s_[28 * 257], s_[29 * 257], s_[30 * 257], s_[31 * 257]); \
        { typedef unsigned u4n_ __attribute__((ext_vector_type(4))); u4n_* d_ = (u4n_*)q_.dst; const u4n_ a_ = {o0_.x, o0_.y, o0_.z, o0_.w}, b_ = {o1_.x, o1_.y, o1_.z, o1_.w}; __builtin_nontemporal_store(a_, d_); __builtin_nontemporal_store(b_, d_ + 1); }     \
        asm volatile("s_waitcnt lgkmcnt(0)\n\ts_barrier" ::: "memory"); } while (0)
__device__ __forceinline__ void ph_wconv_experts(const P& p, char* lds) {
    int tid_ = threadIdx.x; asm volatile("" : "+v"(tid_));
    const int tid = tid_;
    float* scr = (float*)(lds + 32768);
    volatile LAS int* nxt = (volatile LAS int*)(lds + 32768 + 66048);
    constexpr int NITEM = 96 * 64;
    unsigned* ctr = WS(unsigned, W_QCTR) + 8;
    __syncthreads();
    if (tid == 0) { const int base = (int)atomicAdd(ctr, 3u); nxt[0] = base; nxt[1] = base + 1; nxt[2] = base + 2; }
    __syncthreads();
    int i0 = nxt[0], i1 = nxt[1], i2 = nxt[2];
    __syncthreads();
    float4 wa[8], wb[8], wc[8];
    if (i0 < NITEM) WC_LOAD(wa, i0);
    if (i1 < NITEM) WC_LOAD(wb, i1);
#define WC_STEP(WCUR, ICUR, WNEW, INEW, W) do { if (INEW < NITEM) WC_LOAD(WNEW, INEW); if (tid == 0) nxt[W] = (int)atomicAdd(ctr, 1u); WC_FINISH(WCUR, ICUR); ICUR = nxt[W]; } while (0)
    for (;;) {
        if (i0 >= NITEM) break; WC_STEP(wa, i0, wc, i2, 0);
        if (i1 >= NITEM) break; WC_STEP(wb, i1, wa, i0, 1);
        if (i2 >= NITEM) break; WC_STEP(wc, i2, wb, i1, 2);
    }
#undef WC_STEP
    __syncthreads();
}
#undef WC_LOAD
#undef WC_FINISH

__device__ __forceinline__ int moe_tiles(const P& p, int ch, int* tile_e  , int* row_start  ) {
    const int* cnt = WS(int, W_CNT) + ch * 32;
    __syncthreads();
    if (threadIdx.x < 64) { const int e = threadIdx.x & 31; const int nt = (cnt[e] + 255) >> 8;
        int inc = nt;
#pragma unroll
        for (int o = 1; o < 32; o <<= 1) { const int v = __shfl_up(inc, o, 32); if (e >= o) inc += v; }
        const int t0 = inc - nt;
        if (threadIdx.x < 32) { row_start[e] = t0 * 256; for (int i = 0; i < nt; ++i) tile_e[t0 + i] = e; if (e == 31) row_start[32] = inc; } }
    __syncthreads();
    return row_start[32];
}
__device__ __forceinline__ void ph_scatter(const P& p, char* lds) {
    int* tile_e = (int*)(lds + 131072); int* row_start = (int*)(lds + 131072 + 4096);
    for (int ch = 0; ch < NCHUNK; ++ch) {
        (void)moe_tiles(p, ch, tile_e, row_start);
        int* rowtok = WS(int, W_ROWTOK) + ch * MAXROWS;
        for (int i = blockIdx.x * 512 + threadIdx.x; i < CHT * 4; i += gridDim.x * 512) {
            const int a = ch * CHT * 4 + i; const int e = WS(int, W_TOPE)[a]; const int prow = row_start[e] + WS(int, W_BBASE)[(((ch * CHT + (i >> 2)) >> 5) % (int)gridDim.x) * (NCHUNK * 32) + ch * 32 + e] + WS(int, W_POS)[a];
            rowtok[prow] = ch * CHT + (i >> 2); WS(int, W_AROW)[a] = prow; }
    }
}
struct MoeOrder { int nunit, npn_shift; const int* tile_e; int G, c;
    __device__ __forceinline__ bool next(int i, pg8::Unit& u) const { const int L = i * G + c; if (L >= nunit) return false; const int mt = L >> npn_shift; u.pm = mt; u.pn = (tile_e[mt] << npn_shift) + (L & ((1 << npn_shift) - 1)); return true; }
    __device__ __forceinline__ void a_ready(const pg8::Unit&) const {}
    __device__ __forceinline__ void done(const pg8::Unit&) const {} };
struct EpiAct { static constexpr bool PERM = true; static constexpr int NSTORE = 8;
    unsigned char* O; const float* bg; const float* bu;
    __device__ __forceinline__ void operator()(const pg8::f32x4 (&acc)[2][2][4][2], const pg8::Unit& u, int wr, int wc, int fr, int fq) const {
        const int e = u.pn >> 3, pnl = u.pn & 7; const int row0 = u.pm * 256 + wr * 64 + fr, col0 = pnl * 128 + wc * 32 + 8 * fq;
        pg8::f32x4 gb[2], ub[2];
#pragma unroll
        for (int n = 0; n < 2; ++n) { gb[n] = *(const pg8::f32x4*)(bg + e * 1024 + col0 + 4 * n); ub[n] = *(const pg8::f32x4*)(bu + e * 1024 + col0 + 4 * n); }
#pragma unroll
        for (int ai = 0; ai < 2; ++ai)
#pragma unroll
            for (int m = 0; m < 4; ++m) { float o[8];
#pragma unroll
                for (int n = 0; n < 2; ++n)
#pragma unroll
                    for (int j2 = 0; j2 < 2; ++j2) {
                        const pg8::f32x2 ag = {acc[ai][0][m][n][2 * j2], acc[ai][0][m][n][2 * j2 + 1]}, au = {acc[ai][1][m][n][2 * j2], acc[ai][1][m][n][2 * j2 + 1]};
                        const pg8::f32x2 bgv = {gb[n][2 * j2], gb[n][2 * j2 + 1]}, buv = {ub[n][2 * j2], ub[n][2 * j2 + 1]};
                        pg8::f32x2 gt = ag * WSCALE_INV + bgv; gt.x = fminf(gt.x, 7.f); gt.y = fminf(gt.y, 7.f);
                        pg8::f32x2 up = au * WSCALE_INV + buv; up.x = fminf(fmaxf(up.x, -7.f), 7.f); up.y = fminf(fmaxf(up.y, -7.f), 7.f);
                        const pg8::f32x2 t = gt * (-1.702f * 1.4426950408889634f);
                        pg8::f32x2 d; d.x = __builtin_amdgcn_exp2f(t.x); d.y = __builtin_amdgcn_exp2f(t.y); d = d + 1.f;
                        pg8::f32x2 r; r.x = __builtin_amdgcn_rcpf(d.x); r.y = __builtin_amdgcn_rcpf(d.y);
                        const pg8::f32x2 ov = (gt * r) * (up + 1.f);
                        o[n * 4 + 2 * j2] = ov.x; o[n * 4 + 2 * j2 + 1] = ov.y; }
                uint2 w; w.x = pk4_fp8(o[0], o[1], o[2], o[3]); w.y = pk4_fp8(o[4], o[5], o[6], o[7]);
                *(uint2*)(O + (size_t)(row0 + ai * 128 + m * 16) * 1024 + col0) = w; }
    }
};
struct EpiDown { static constexpr bool PERM = true; static constexpr int NSTORE = 8;
    unsigned char* O; const float* bd;
    __device__ __forceinline__ void operator()(const pg8::f32x4 (&acc)[2][2][4][2], const pg8::Unit& u, int wr, int wc, int fr, int fq) const {
        const int e = u.pn >> 2, pnl = u.pn & 3; const int row0 = u.pm * 256 + wr * 64 + fr, col0 = pnl * 256 + wc * 64 + 16 * fq;
        pg8::f32x4 bv[2][2];
#pragma unroll
        for (int bj = 0; bj < 2; ++bj)
#pragma unroll
            for (int n = 0; n < 2; ++n) bv[bj][n] = *(const pg8::f32x4*)(bd + e * 1024 + col0 + 8 * bj + 4 * n);
#pragma unroll
        for (int ai = 0; ai < 2; ++ai)
#pragma unroll
            for (int m = 0; m < 4; ++m) { unsigned char* rowp = O + (size_t)(row0 + ai * 128 + m * 16) * 1024 + col0;
                uint4 w;
                { const pg8::f32x4 v0 = acc[ai][0][m][0] * WSCALE_INV + bv[0][0], v1 = acc[ai][0][m][1] * WSCALE_INV + bv[0][1]; w.x = pk4_fp8(v0[0], v0[1], v0[2], v0[3]); w.y = pk4_fp8(v1[0], v1[1], v1[2], v1[3]); }
                { const pg8::f32x4 v0 = acc[ai][1][m][0] * WSCALE_INV + bv[1][0], v1 = acc[ai][1][m][1] * WSCALE_INV + bv[1][1]; w.z = pk4_fp8(v0[0], v0[1], v0[2], v0[3]); w.w = pk4_fp8(v1[0], v1[1], v1[2], v1[3]); }
                *(uint4*)rowp = w; }
    }
};
struct EpiNone { static constexpr bool PERM = true; static constexpr int NSTORE = 0;
    __device__ __forceinline__ void operator()(const pg8::f32x4 (&acc)[2][2][4][2], const pg8::Unit& u, int wr, int wc, int fr, int fq) const {
        float s = 0.f;
#pragma unroll
        for (int ai = 0; ai < 2; ++ai)
#pragma unroll
            for (int bj = 0; bj < 2; ++bj)
#pragma unroll
                for (int mm = 0; mm < 4; ++mm)
#pragma unroll
                    for (int n = 0; n < 2; ++n) s += acc[ai][bj][mm][n][0] + acc[ai][bj][mm][n][1] + acc[ai][bj][mm][n][2] + acc[ai][bj][mm][n][3];
        if (s == 1.2345e30f) sink[0] = s; }
    float* sink; };
template <int CH, int VAR = 0>
__device__ __forceinline__ void ph_moe_gu(const P& p, char* lds) {
    int* tile_e = (int*)(lds + 131072); int* row_start = (int*)(lds + 131072 + 4096);
    const int ntile = moe_tiles(p, CH, tile_e, row_start);
    pg8::Gemm g{(const bf16_t*)WS(unsigned char, W_H2B), (const bf16_t*)WS(unsigned char, W_WGU), 512};
    MoeOrder S{ntile * 8, 3, tile_e, (int)gridDim.x, (int)blockIdx.x};
    pg8::RowsGather AM{WS(int, W_ROWTOK) + CH * MAXROWS, 1024u};
    if constexpr (VAR == 1) { EpiNone E{WS(float, W_BAR) + 16000}; pg8::gemm_phase<EpiNone, MoeOrder, pg8::RowsGather, true, 1>((PG8_LAS unsigned char*)lds, g, S, E, AM); }
    else { EpiAct E{WS(unsigned char, W_ACTB), p.in[25], p.in[27]}; pg8::gemm_phase<EpiAct, MoeOrder, pg8::RowsGather, true, 1>((PG8_LAS unsigned char*)lds, g, S, E, AM); }
}
struct RowsWrap { static constexpr bool DENSE = false; unsigned pitch;
    __device__ __forceinline__ unsigned off(int pm, int r) const { return (unsigned)((pm * 256 + r) & (T_ - 1)) * pitch; } };
template <int CH, int VAR = 0>
__device__ __forceinline__ void ph_moe_dn(const P& p, char* lds) {
    int* tile_e = (int*)(lds + 131072); int* row_start = (int*)(lds + 131072 + 4096);
    const int ntile = moe_tiles(p, CH, tile_e, row_start);
    MoeOrder S{ntile * 4, 2, tile_e, (int)gridDim.x, (int)blockIdx.x};
    if constexpr (VAR == 1) {
        pg8::Gemm g{(const bf16_t*)WS(unsigned char, W_ACTB), (const bf16_t*)WS(unsigned char, W_WDN), 512};
        EpiNone E{WS(float, W_BAR) + 16000}; pg8::RowsDenseL AM{1024u};
        pg8::gemm_phase<EpiNone, MoeOrder, pg8::RowsDenseL, true, 1>((PG8_LAS unsigned char*)lds, g, S, E, AM);
    } else if constexpr (VAR == 2) {
        pg8::Gemm g{(const bf16_t*)WS(unsigned char, W_H2B), (const bf16_t*)WS(unsigned char, W_WDN), 512};
        EpiDown E{WS(unsigned char, W_YPB), p.in[29]}; RowsWrap AM{1024u};
        pg8::gemm_phase<EpiDown, MoeOrder, RowsWrap, true, 1>((PG8_LAS unsigned char*)lds, g, S, E, AM);
    } else {
        pg8::Gemm g{(const bf16_t*)WS(unsigned char, W_ACTB), (const bf16_t*)WS(unsigned char, W_WDN), 512};
        EpiDown E{WS(unsigned char, W_YPB), p.in[29]}; pg8::RowsDenseL AM{1024u};
        pg8::gemm_phase<EpiDown, MoeOrder, pg8::RowsDenseL, false, 1>((PG8_LAS unsigned char*)lds, g, S, E, AM);
    }
}
template <int CH>
__device__ __forceinline__ void ph_final_fast(const P& p, float* outb, int ostride) {
    int tidL_ = threadIdx.x; asm volatile("" : "+v"(tidL_));
    const int lane = tidL_ & 63;
    const float* ada = WS(float, W_ADA);
    const unsigned char* yp = WS(unsigned char, W_YPB);
    float4 gnv[4], bsv[4];
#pragma unroll
    for (int j = 0; j < 4; ++j) { gnv[j] = *(const float4*)(p.in[30] + j * 256 + lane * 4); bsv[j] = *(const float4*)(p.in[31] + j * 256 + lane * 4); }
    for (int ul0 = (blockIdx.x * 8 + (tidL_ >> 6)) * 2; ul0 < CHT; ul0 += gridDim.x * 16) {
        int ar[2][4]; float tw[2][4];
#pragma unroll
        for (int tt = 0; tt < 2; ++tt)
#pragma unroll
            for (int k = 0; k < 4; ++k) { const int a = (CH * CHT + ul0 + tt) * 4 + k; ar[tt][k] = WS(int, W_AROW)[a]; tw[tt][k] = WS(float, W_TOPW)[a]; }
        int yv[2][4][4]; uint2 xb[2][4];
#pragma unroll
        for (int tt = 0; tt < 2; ++tt) { const bf16_t* xrow = WS(bf16_t, W_X1B) + (size_t)(CH * CHT + ul0 + tt) * 1024;
#pragma unroll
            for (int j = 0; j < 4; ++j) xb[tt][j] = ldnt2(xrow + j * 256 + lane * 4);
#pragma unroll
            for (int k = 0; k < 4; ++k) { const unsigned char* yr = yp + (size_t)ar[tt][k] * 1024;
#pragma unroll
                for (int j = 0; j < 4; ++j) yv[tt][k][j] = __builtin_nontemporal_load((const int*)(yr + j * 256 + lane * 4)); } }
#pragma unroll
        for (int tt = 0; tt < 2; ++tt) {
            const int u = CH * CHT + ul0 + tt, b = u >> 11;
            float4 z[4]; float s = 0.f;
#pragma unroll
            for (int j = 0; j < 4; ++j) { float4 y = make_float4(0.f, 0.f, 0.f, 0.f);
#pragma unroll
                for (int k = 0; k < 4; ++k) { const f32x2_t lo = __builtin_amdgcn_cvt_pk_f32_fp8(yv[tt][k][j], false), hi2 = __builtin_amdgcn_cvt_pk_f32_fp8(yv[tt][k][j], true); const float w = tw[tt][k];
                    y.x += w * lo[0]; y.y += w * lo[1]; y.z += w * hi2[0]; y.w += w * hi2[1]; }
                const int c = j * 256 + lane * 4; const float4 xv = make_float4(blo(xb[tt][j].x), bhi(xb[tt][j].x), blo(xb[tt][j].y), bhi(xb[tt][j].y)); const float4 gv = *(const float4*)(ada + b * 6144 + 5120 + c);
                z[j] = make_float4(ALPHA * xv.x + (1.f + gv.x) * y.x, ALPHA * xv.y + (1.f + gv.y) * y.y, ALPHA * xv.z + (1.f + gv.z) * y.z, ALPHA * xv.w + (1.f + gv.w) * y.w);
                s += (z[j].x + z[j].y) + (z[j].z + z[j].w); }
            const float mu = wsum(s) * (1.f / 1024.f); float q = 0.f;
#pragma unroll
            for (int j = 0; j < 4; ++j) { z[j].x -= mu; z[j].y -= mu; z[j].z -= mu; z[j].w -= mu; q += (z[j].x * z[j].x + z[j].y * z[j].y) + (z[j].z * z[j].z + z[j].w * z[j].w); }
            const float rs = rsqrtf(wsum(q) * (1.f / 1024.f) + 1e-5f);
#pragma unroll
            for (int j = 0; j < 4; ++j) { const int c = j * 256 + lane * 4; const float4 gn = gnv[j], bs = bsv[j];
                typedef float f32x4n_t __attribute__((ext_vector_type(4))); const f32x4n_t ov = {z[j].x * rs * gn.x + bs.x, z[j].y * rs * gn.y + bs.y, z[j].z * rs * gn.z + bs.z, z[j].w * rs * gn.w + bs.w};
                __builtin_nontemporal_store(ov, (f32x4n_t*)(outb + (size_t)u * ostride + c)); }
        }
    }
}

#ifndef PROBE
#define PROBE 0
#endif
constexpr int LDS_BYTES = 151552;
static_assert(MAXROWS / 256 * 4 <= 4096, "tile table");
__global__ void __launch_bounds__(512, 2) mega(P p) {
    extern __shared__ __attribute__((aligned(16))) char lds[];
    if (threadIdx.x == 0) { *(uint4*)(lds + LDS_BYTES - 16) = make_uint4(0u, 0u, 0u, 0u); }
    __syncthreads();
    XcdBarrier bar = xcd_barrier_post(WS(unsigned, W_BAR), (volatile LAS unsigned*)(lds + LDS_BYTES - 16));
#define RUN(id, ...) do { __VA_ARGS__; if (PROBE == (id)) { xcd_barrier(bar); __VA_ARGS__; } } while (0)
#define RUNX(id, first, ...) do { if (PROBE == (id)) { first; xcd_barrier(bar); } __VA_ARGS__; } while (0)
    bf16_t* const onsa = WS(bf16_t, W_ONSA); bf16_t* const dummy = WS(bf16_t, W_MIXB);
    RUN(1, ph_pre(p, lds));                                   xcd_barrier(bar);
    RUN(2, ph_hmod(p));                                       xcd_barrier(bar);
    RUN(3, ph_win(p, lds));                                   xcd_barrier(bar);
    RUNX(4, ph_nsa_attn<0>(p, lds, dummy, 1), ph_compress(p, lds); if ((blockIdx.x & 1u) && blockIdx.x >= 32u) ph_wconv_experts(p, lds); ph_prep(p); ph_nsa_attn<0>(p, lds, onsa, 0); ph_wconv_experts(p, lds)); xcd_barrier(bar);
    RUNX(21, ph_dsa_index<3>(p, lds, (unsigned long long*)WS(float, W_MIXB)), (void)0);
    RUNX(22, ph_dsa_index<1>(p, lds, (unsigned long long*)WS(float, W_MIXB)), (void)0);
    RUNX(23, ph_dsa_index<2>(p, lds, (unsigned long long*)WS(float, W_MIXB)), (void)0);
    ph_dsa_index<3>(p, lds, WS(unsigned long long, W_DMASK));                             xcd_barrier(bar);
    RUNX(6, ph_nsa_cmp(p, lds, dummy), ph_nsa_cmp(p, lds, onsa)); RUN(7, ph_dsa_attn(p, lds)); xcd_barrier(bar);
    RUNX(8, ph_nsa_attn<1>(p, lds, dummy, 0), ph_nsa_attn<1>(p, lds, onsa, 0)); xcd_barrier(bar);
    RUN(9, ph_combine(p));                                    xcd_barrier(bar);
    RUN(10, ph_wout(p, lds));                                 xcd_barrier(bar);
    RUNX(18, ph_lnroute_fast<1>(p, lds, (bf16_t*)WS(float, W_COLS), (unsigned char*)WS(float, W_ONSA), WS(int, W_QCTR) + 64, (int*)WS(float, W_ODSA), WS(float, W_ODSA) + 262144, (int*)WS(float, W_ODSA) + 524288, (int*)WS(float, W_ODSA) + 1048576), (void)0);
    RUNX(19, ph_lnroute_fast<3>(p, lds, (bf16_t*)WS(float, W_COLS), (unsigned char*)WS(float, W_ONSA), WS(int, W_QCTR) + 64, (int*)WS(float, W_ODSA), WS(float, W_ODSA) + 262144, (int*)WS(float, W_ODSA) + 524288, (int*)WS(float, W_ODSA) + 1048576), (void)0);
    RUNX(15, ph_lnroute_fast<7>(p, lds, (bf16_t*)WS(float, W_COLS), (unsigned char*)WS(float, W_ONSA), WS(int, W_QCTR) + 64, (int*)WS(float, W_ODSA), WS(float, W_ODSA) + 262144, (int*)WS(float, W_ODSA) + 524288, (int*)WS(float, W_ODSA) + 1048576),
         ph_lnroute_fast<7>(p, lds, WS(bf16_t, W_X1B), WS(unsigned char, W_H2B), WS(int, W_CNT), WS(int, W_TOPE), WS(float, W_TOPW), WS(int, W_POS), WS(int, W_BBASE))); xcd_barrier(bar);
    RUN(17, ph_scatter(p, lds));    xcd_barrier(bar);
    RUNX(26, (ph_moe_gu<0, 1>(p, lds)), (void)0);
    RUN(12, ph_moe_gu<0>(p, lds));                            xcd_barrier(bar);
    RUNX(24, (ph_moe_dn<0, 1>(p, lds)), (void)0); RUNX(25, (ph_moe_dn<0, 2>(p, lds)), (void)0);
    RUN(13, ph_moe_dn<0>(p, lds));                            xcd_barrier(bar);
    ph_final_fast<0>(p, p.out, 1024);
    if (PROBE == 14) { for (int i = 0; i < 10; ++i) xcd_barrier(bar); }
}
}

extern "C" void kernel_launch(void* const* d_in, const int* in_sizes, int n_in, void* d_out, int out_size, void* d_ws, size_t ws_size, hipStream_t stream) {
    P p{};
    for (int i = 0; i < 32; ++i) p.in[i] = (const float*)d_in[i];
    p.out = (float*)d_out; p.ws = (unsigned char*)d_ws;
    static int grid = 0;
    if (!grid) {
        int dev = 0, cus = 0, per_cu = 0;
        (void)hipGetDevice(&dev);
        (void)hipDeviceGetAttribute(&cus, hipDeviceAttributeMultiprocessorCount, dev);
        (void)hipFuncSetAttribute((const void*)mega, hipFuncAttributeMaxDynamicSharedMemorySize, LDS_BYTES);
        (void)hipOccupancyMaxActiveBlocksPerMultiprocessor(&per_cu, mega, 512, LDS_BYTES);
        grid = cus * (per_cu < 1 ? per_cu : 1);
        if (grid <= 0) grid = 256;
    }
    (void)hipMemsetAsync(d_ws, 0, 65536, stream);
    mega<<<grid, 512, LDS_BYTES, stream>>>(p);
}
```
